# Optimizing an MI355X kernel written in HIP

```python
import jax, jax.numpy as jnp
from jax import lax
import numpy as np

D_MODEL = 1024
BATCH = 4
SEQ = 8192
DEPTH = 1

CHUNK = 64
LEFT_CHUNKS = 8
BAND = (LEFT_CHUNKS + 1) * CHUNK
N_HEADS = 8
HEAD_DIM = 64
D_ATTN = N_HEADS * HEAD_DIM
REL_CLIP = 128
D_CONV = 512
CONV_WIDTH = 31
N_BRANCH = 2
D_IN = 3 * D_ATTN + 2 * D_CONV + N_BRANCH * D_MODEL
D_FF = 2816
EPS = 1e-6

kernel_name = "hybrid_chunked_attn_conformer_conv_macaron"


def rms_norm(x, g):
    xf = x.astype(jnp.float32)
    y = xf * lax.rsqrt(jnp.mean(xf * xf, axis=-1, keepdims=True) + EPS)
    return (y * g.astype(jnp.float32)).astype(x.dtype)


def layer_norm(x, g, b):
    xf = x.astype(jnp.float32)
    mu = jnp.mean(xf, axis=-1, keepdims=True)
    var = jnp.mean(jnp.square(xf - mu), axis=-1, keepdims=True)
    y = (xf - mu) * lax.rsqrt(var + EPS)
    return (y * g.astype(jnp.float32) + b.astype(jnp.float32)).astype(x.dtype)


def swiglu(x, w_gate, w_up, w_down):
    return (jax.nn.silu(x @ w_gate) * (x @ w_up)) @ w_down


def chunked_attention(q, k, v, rel_table):
    B, S, H, Dh = q.shape
    nc = S // CHUNK
    qc = q.reshape(B, nc, CHUNK, H, Dh)
    pad = ((0, 0), (LEFT_CHUNKS, 0), (0, 0), (0, 0), (0, 0))
    kp = jnp.pad(k.reshape(B, nc, CHUNK, H, Dh), pad)
    vp = jnp.pad(v.reshape(B, nc, CHUNK, H, Dh), pad)
    k_band = jnp.concatenate([kp[:, j:j + nc] for j in range(LEFT_CHUNKS + 1)], axis=2)
    v_band = jnp.concatenate([vp[:, j:j + nc] for j in range(LEFT_CHUNKS + 1)], axis=2)
    scores = jnp.einsum('bnqhd,bnkhd->bnhqk', qc, k_band).astype(jnp.float32) * (HEAD_DIM ** -0.5)
    qi = jnp.arange(CHUNK)[:, None]
    kj = jnp.arange(BAND)[None, :]
    dist = qi + LEFT_CHUNKS * CHUNK - kj
    idx = jnp.clip(dist, -REL_CLIP, REL_CLIP) + REL_CLIP
    bias = rel_table.astype(jnp.float32)[:, idx]
    scores = scores + bias[None, None]
    key_chunk = jnp.arange(nc)[:, None] + (jnp.arange(BAND) // CHUNK)[None, :] - LEFT_CHUNKS
    valid = (key_chunk >= 0)[None, :, None, None, :]
    scores = jnp.where(valid, scores, jnp.float32(-1e30))
    p = jax.nn.softmax(scores, axis=-1).astype(v.dtype)
    out = jnp.einsum('bnhqk,bnkhd->bnqhd', p, v_band)
    return out.reshape(B, S, H * Dh)


def conv_module(c_in, glu_bias, dw_w, dw_b, ln_g, ln_b, w_out):
    c = c_in + glu_bias
    c = c[..., :D_CONV] * jax.nn.sigmoid(c[..., D_CONV:])
    c = lax.conv_general_dilated(
        c, dw_w.astype(c.dtype), window_strides=(1,), padding=((CONV_WIDTH - 1, 0),),
        dimension_numbers=('NWC', 'WIO', 'NWC'), feature_group_count=D_CONV) + dw_b
    c = jax.nn.silu(layer_norm(c, ln_g, ln_b))
    return c @ w_out


def hybrid_mixer(u, w_in, gate_bias, rel_table, w_attn_out, conv_glu_bias, conv_dw_w,
                 conv_dw_b, conv_ln_g, conv_ln_b, conv_w_out, w_out):
    B, S, _ = u.shape
    proj = u @ w_in
    q, k, v, c_in, g = jnp.split(
        proj, [D_ATTN, 2 * D_ATTN, 3 * D_ATTN, 3 * D_ATTN + 2 * D_CONV], axis=-1)
    shp = (B, S, N_HEADS, HEAD_DIM)
    y_a = chunked_attention(q.reshape(shp), k.reshape(shp), v.reshape(shp), rel_table) @ w_attn_out
    y_b = conv_module(c_in, conv_glu_bias, conv_dw_w, conv_dw_b, conv_ln_g, conv_ln_b, conv_w_out)
    gates = jax.nn.sigmoid(g + gate_bias)
    merged = gates[..., :D_MODEL] * y_a + gates[..., D_MODEL:] * y_b
    return merged @ w_out


def setup_inputs(seed: int = 0) -> dict:
    key = jax.random.key(seed)
    ks = jax.random.split(key, 32)
    L, D = DEPTH, D_MODEL

    def w(k, shape, fan_in):
        return jax.random.normal(k, shape, jnp.float32) * (fan_in ** -0.5)

    def gain(k, shape):
        return 1.0 + 0.05 * jax.random.normal(k, shape, jnp.float32)

    def small(k, shape, s=0.02):
        return s * jax.random.normal(k, shape, jnp.float32)

    return {
        "x": jax.random.normal(ks[0], (BATCH, SEQ, D), jnp.float32),
        "ffn1_norm_pre": gain(ks[1], (L, D)),
        "ffn1_w_gate": w(ks[2], (L, D, D_FF), D),
        "ffn1_w_up": w(ks[3], (L, D, D_FF), D),
        "ffn1_w_down": w(ks[4], (L, D_FF, D), D_FF),
        "ffn1_norm_post": gain(ks[5], (L, D)),
        "mix_norm_pre": gain(ks[6], (L, D)),
        "w_in": w(ks[7], (L, D, D_IN), D),
        "gate_bias": small(ks[8], (L, N_BRANCH * D), 0.1),
        "rel_table": small(ks[9], (L, N_HEADS, 2 * REL_CLIP + 1), 0.5),
        "w_attn_out": w(ks[10], (L, D_ATTN, D), D_ATTN),
        "conv_glu_bias": small(ks[11], (L, 2 * D_CONV)),
        "conv_dw_w": w(ks[12], (L, CONV_WIDTH, 1, D_CONV), CONV_WIDTH),
        "conv_dw_b": small(ks[13], (L, D_CONV)),
        "conv_ln_g": gain(ks[14], (L, D_CONV)),
        "conv_ln_b": small(ks[15], (L, D_CONV)),
        "conv_w_out": w(ks[16], (L, D_CONV, D), D_CONV),
        "w_out": w(ks[17], (L, D, D), D),
        "mix_norm_post": gain(ks[18], (L, D)),
        "ffn2_norm_pre": gain(ks[19], (L, D)),
        "ffn2_w_gate": w(ks[20], (L, D, D_FF), D),
        "ffn2_w_up": w(ks[21], (L, D, D_FF), D),
        "ffn2_w_down": w(ks[22], (L, D_FF, D), D_FF),
        "ffn2_norm_post": gain(ks[23], (L, D)),
    }


def reference(x, ffn1_norm_pre, ffn1_w_gate, ffn1_w_up, ffn1_w_down, ffn1_norm_post,
              mix_norm_pre, w_in, gate_bias, rel_table, w_attn_out, conv_glu_bias,
              conv_dw_w, conv_dw_b, conv_ln_g, conv_ln_b, conv_w_out, w_out, mix_norm_post,
              ffn2_norm_pre, ffn2_w_gate, ffn2_w_up, ffn2_w_down, ffn2_norm_post):
    h = x
    for l in range(DEPTH):
        f = swiglu(rms_norm(h, ffn1_norm_pre[l]), ffn1_w_gate[l], ffn1_w_up[l], ffn1_w_down[l])
        h = h + 0.5 * rms_norm(f, ffn1_norm_post[l])
        m = hybrid_mixer(rms_norm(h, mix_norm_pre[l]), w_in[l], gate_bias[l], rel_table[l],
                         w_attn_out[l], conv_glu_bias[l], conv_dw_w[l], conv_dw_b[l],
                         conv_ln_g[l], conv_ln_b[l], conv_w_out[l], w_out[l])
        h = h + rms_norm(m, mix_norm_post[l])
        f = swiglu(rms_norm(h, ffn2_norm_pre[l]), ffn2_w_gate[l], ffn2_w_up[l], ffn2_w_down[l])
        h = h + 0.5 * rms_norm(f, ffn2_norm_post[l])
    return h
```

```cpp
#include <hip/hip_runtime.h>
#include <hip/hip_cooperative_groups.h>
#include <cstdio>
#include <cstdint>
namespace cg = cooperative_groups;
namespace pg8 {
#define PG8_LAS __attribute__((address_space(3)))
typedef unsigned short bf16_t;
typedef short bf16x8 __attribute__((ext_vector_type(8)));
typedef float f32x4 __attribute__((ext_vector_type(4)));
typedef unsigned u32x4 __attribute__((ext_vector_type(4)));
constexpr int BM = 256, BK = 64, HALF = 128, HTB = HALF * BK * 2  , STAGE_BYTES = 8 * HTB, NXCD = 8, WGM = 8;

__host__ __device__ __forceinline__ int lds_byte(int r, int c) { const int st = (r >> 4) * 2 + (c >> 5), rr = r & 15, cc = c & 31, ob = rr * 64 + cc * 2; return st * 1024 + (ob ^ (((ob >> 9) & 1) << 5)); }
__host__ __device__ __forceinline__ void stage_rc(int b, int& R, int& C) { const int st = b / 1024, sb = b % 1024, swz = sb ^ (((sb >> 9) & 1) << 5); R = (st >> 1) * 16 + swz / 64; C = (st & 1) * 32 + (swz % 64) / 2; }
__host__ __device__ __forceinline__ int perm32(int rho) { const int n = rho >> 4, i = rho & 15; return 8 * (i >> 2) + 4 * n + (i & 3); }

struct Unit { int pm, pn, kh; };
struct Gemm { const bf16_t* A; const bf16_t* Bt; int M, N, K, ld; };

struct StaticOrder {
    int nM, nN, nwg, G, c;
    __host__ __device__ void init(int M, int N, int G_, int c_) { nM = M / BM; nN = N / BM; nwg = nM * nN; G = G_; c = c_; }
    __host__ __device__ bool next(int i, Unit& u) const {
        const long L = (long)i * G + c; if (L >= nwg) return false;
        int wgid = (int)L; { const int q = nwg / NXCD, r = nwg % NXCD, xcd = wgid % NXCD, off = wgid / NXCD; wgid = (xcd < r ? xcd * (q + 1) : r * (q + 1) + (xcd - r) * q) + off; }
        const int nig = WGM * nN, gid = wgid / nig, fm = gid * WGM, gsz = (nM - fm) < WGM ? (nM - fm) : WGM;
        u.pm = fm + ((wgid % nig) % gsz); u.pn = (wgid % nig) / gsz; u.kh = 0; return true;
    }
    __device__ __forceinline__ void a_ready(const Unit&) const {}
    __device__ __forceinline__ void done(const Unit&) const {}
};

struct HalfOrder {
    StaticOrder so;
    __host__ __device__ void init(int M, int N, int G_, int c_) { so.init(M, N, G_, c_); }
    __host__ __device__ bool next(int i, Unit& u) const { if (!so.next(i >> 1, u)) return false; u.kh = i & 1; return true; }
    __device__ __forceinline__ void a_ready(const Unit&) const {}
    __device__ __forceinline__ void done(const Unit&) const {}
};
typedef float f32x2 __attribute__((ext_vector_type(2)));
typedef __bf16 bf16x2v __attribute__((ext_vector_type(2)));
__device__ __forceinline__ unsigned cvt_pk_bf16(float lo, float hi) { f32x2 v = {lo, hi}; bf16x2v b = __builtin_convertvector(v, bf16x2v); return __builtin_bit_cast(unsigned, b); }
template <class Epi, class Sched, bool ALIGN_EPI = false, bool SP2 = false>
__device__ __forceinline__ void gemm_phase(PG8_LAS unsigned char* lds, const Gemm g, const Sched& S, const Epi& E) {
    const int tid = threadIdx.x, wid = __builtin_amdgcn_readfirstlane(tid >> 6), lane = tid & 63, wr = wid >> 2, wc = wid & 3, fr = lane & 15, fq = lane >> 4;
    const int K = g.ld, nt = g.K / BK;
    unsigned voffA[2], voffB[2];
#pragma unroll
    for (int i = 0; i < 2; ++i) { int R, C; stage_rc(tid * 16 + i * 8192, R, C); const int Rb = Epi::PERM ? ((R & ~31) + perm32(R & 31)) : R;
        voffA[i] = (unsigned)(R * K + C) * 2u; voffB[i] = (unsigned)(Rb * K + C) * 2u; }
    const size_t kstep = (size_t)(BK * 2);
    const size_t hstep = (size_t)HALF * K * 2;
    const size_t tstep = 2 * hstep;
    const unsigned ldsw = (unsigned)wid * 1024u;
    const int aoff = lds_byte(wr * 64 + fr, fq * 8), boff = lds_byte(wc * 32 + fr, fq * 8);
#define PG8_SA(b, h) (((b) * 2 + (h)) * HTB)
#define PG8_SB(b, h) ((4 + (b) * 2 + (h)) * HTB)
#define PG8_STAGE(bufoff, gbase, voff) do { _Pragma("unroll") for (int _i = 0; _i < 2; ++_i) \
        __builtin_amdgcn_global_load_lds((const unsigned*)((const char*)(gbase) + (voff)[_i]), (PG8_LAS unsigned*)(lds + (bufoff) + ldsw + _i * 8192), 16, 0, 0); } while (0)
#define PG8_LDA(dst, b, h) do { _Pragma("unroll") for (int m = 0; m < 4; ++m) _Pragma("unroll") for (int k = 0; k < 2; ++k) dst[m][k] = *(const PG8_LAS bf16x8*)(lds + PG8_SA(b, h) + aoff + m * 2048 + k * 1024); } while (0)
#define PG8_LDB(dst, b, h) do { _Pragma("unroll") for (int n = 0; n < 2; ++n) _Pragma("unroll") for (int k = 0; k < 2; ++k) dst[n][k] = *(const PG8_LAS bf16x8*)(lds + PG8_SB(b, h) + boff + n * 2048 + k * 1024); } while (0)
#define PG8_MMA(ai, bj, At, Bt) do { __builtin_amdgcn_s_setprio(1); _Pragma("unroll") for (int m = 0; m < 4; ++m) _Pragma("unroll") for (int n = 0; n < 2; ++n) _Pragma("unroll") for (int k = 0; k < 2; ++k) \
        acc[ai][bj][m][n] = __builtin_amdgcn_mfma_f32_16x16x32_bf16(Bt[n][k], At[m][k], acc[ai][bj][m][n], 0, 0, 0); __builtin_amdgcn_s_setprio(0); } while (0)
#define PG8_WAIT_V(n) asm volatile("s_waitcnt vmcnt(" #n ")" ::: "memory")
#define PG8_WAIT_L(n) asm volatile("s_waitcnt lgkmcnt(" #n ")" ::: "memory")
#define PG8_BAR __builtin_amdgcn_s_barrier()
#define PG8_SCHED __builtin_amdgcn_sched_barrier(0)
    Unit cur, nxt; int ui = 0;
    if (!S.next(0, cur)) return;
    f32x4 acc[2][2][4][2];
#pragma unroll
    for (int a = 0; a < 2; ++a)
#pragma unroll
        for (int b = 0; b < 2; ++b)
#pragma unroll
            for (int m = 0; m < 4; ++m)
#pragma unroll
                for (int n = 0; n < 2; ++n) acc[a][b][m][n] = (f32x4){0.f, 0.f, 0.f, 0.f};
    bf16x8 At[4][2], B0[2][2], B1[2][2];
    const size_t khstep = (size_t)g.K * 2;
    const char* cA = (const char*)g.A + (size_t)cur.pm * tstep + cur.kh * khstep; const char* cB = (const char*)g.Bt + (size_t)cur.pn * tstep + cur.kh * khstep;
    S.a_ready(cur);
    if constexpr (SP2) {
        PG8_STAGE(PG8_SB(0, 0), cB, voffB); PG8_STAGE(PG8_SB(0, 1), cB + hstep, voffB); PG8_STAGE(PG8_SA(0, 0), cA, voffA); PG8_STAGE(PG8_SA(0, 1), cA + hstep, voffA);
        if (wr == 1) PG8_BAR;
        PG8_WAIT_V(2); PG8_BAR;
        PG8_STAGE(PG8_SB(1, 0), cB + kstep, voffB); PG8_STAGE(PG8_SA(1, 0), cA + kstep, voffA); PG8_STAGE(PG8_SB(1, 1), cB + hstep + kstep, voffB);
        PG8_WAIT_V(6); PG8_BAR;
    } else {
        PG8_STAGE(PG8_SB(0, 0), cB, voffB); PG8_STAGE(PG8_SA(0, 0), cA, voffA); PG8_STAGE(PG8_SB(0, 1), cB + hstep, voffB); PG8_STAGE(PG8_SA(0, 1), cA + hstep, voffA);
        if (wr == 1) PG8_BAR;
        PG8_WAIT_V(4); PG8_BAR;
        PG8_STAGE(PG8_SB(1, 0), cB + kstep, voffB); PG8_STAGE(PG8_SA(1, 0), cA + kstep, voffA); PG8_STAGE(PG8_SB(1, 1), cB + hstep + kstep, voffB);
        PG8_WAIT_V(6); PG8_BAR;
    }
    for (;;) {
        const bool has_next = S.next(ui + 1, nxt);
        const char* nA = has_next ? (const char*)g.A + (size_t)nxt.pm * tstep + nxt.kh * khstep : cA; const char* nB = has_next ? (const char*)g.Bt + (size_t)nxt.pn * tstep + nxt.kh * khstep : cB;
        for (int t = 0; t < nt; t += 2) {
            const bool last = (t == nt - 2);
            const char* a1 = cA + (size_t)(t + 1) * kstep;
            const char* a2 = last ? nA : cA + (size_t)(t + 2) * kstep; const char* b2 = last ? nB : cB + (size_t)(t + 2) * kstep;
            const char* a3 = a2 + kstep; const char* b3 = b2 + kstep;
            if (last && has_next) S.a_ready(nxt);
            if constexpr (SP2) {
            PG8_LDB(B0, 0, 0); PG8_LDB(B1, 0, 1); PG8_SCHED; PG8_LDA(At, 0, 0); PG8_STAGE(PG8_SA(1, 1), a1 + hstep, voffA);
            PG8_WAIT_V(8); PG8_WAIT_L(0); PG8_BAR; PG8_MMA(0, 0, At, B0); PG8_MMA(0, 1, At, B1); PG8_BAR; PG8_SCHED;
            PG8_LDA(At, 0, 1); PG8_STAGE(PG8_SB(0, 0), b2, voffB); PG8_STAGE(PG8_SB(0, 1), b2 + hstep, voffB); PG8_STAGE(PG8_SA(0, 0), a2, voffA);
            PG8_WAIT_V(8); PG8_WAIT_L(0); PG8_BAR; PG8_MMA(1, 0, At, B0); PG8_MMA(1, 1, At, B1); PG8_BAR; PG8_SCHED;
            PG8_LDB(B0, 1, 0); PG8_LDB(B1, 1, 1); PG8_SCHED; PG8_LDA(At, 1, 0); PG8_STAGE(PG8_SA(0, 1), a2 + hstep, voffA);
            PG8_WAIT_V(8); PG8_WAIT_L(0); PG8_BAR; PG8_MMA(0, 0, At, B0); PG8_MMA(0, 1, At, B1); PG8_BAR; PG8_SCHED;
            PG8_LDA(At, 1, 1); PG8_STAGE(PG8_SB(1, 0), b3, voffB); PG8_STAGE(PG8_SB(1, 1), b3 + hstep, voffB); PG8_STAGE(PG8_SA(1, 0), a3, voffA);
            PG8_WAIT_V(8); PG8_WAIT_L(0); PG8_BAR; PG8_MMA(1, 0, At, B0); PG8_MMA(1, 1, At, B1); PG8_BAR; PG8_SCHED;
            } else {
            PG8_LDB(B0, 0, 0); PG8_SCHED; PG8_LDA(At, 0, 0); PG8_STAGE(PG8_SA(1, 1), a1 + hstep, voffA);
            PG8_WAIT_L(8); PG8_BAR; PG8_WAIT_L(0); PG8_MMA(0, 0, At, B0); PG8_BAR; PG8_SCHED;
            PG8_LDB(B1, 0, 1); PG8_STAGE(PG8_SB(0, 0), b2, voffB);
            PG8_BAR; PG8_WAIT_L(0); PG8_MMA(0, 1, At, B1); PG8_BAR;
            PG8_LDA(At, 0, 1); PG8_STAGE(PG8_SA(0, 0), a2, voffA);
            PG8_BAR; PG8_WAIT_L(0); PG8_MMA(1, 0, At, B0); PG8_BAR; PG8_SCHED;
            PG8_STAGE(PG8_SB(0, 1), b2 + hstep, voffB);
            PG8_WAIT_V(6); PG8_BAR; PG8_MMA(1, 1, At, B1); PG8_BAR;
            PG8_LDB(B0, 1, 0); PG8_SCHED; PG8_LDA(At, 1, 0); PG8_STAGE(PG8_SA(0, 1), a2 + hstep, voffA);
            PG8_WAIT_L(8); PG8_BAR; PG8_WAIT_L(0); PG8_MMA(0, 0, At, B0); PG8_BAR; PG8_SCHED;
            PG8_LDB(B1, 1, 1); PG8_STAGE(PG8_SB(1, 0), b3, voffB);
            PG8_BAR; PG8_WAIT_L(0); PG8_MMA(0, 1, At, B1); PG8_BAR;
            PG8_LDA(At, 1, 1); PG8_STAGE(PG8_SA(1, 0), a3, voffA);
            PG8_BAR; PG8_WAIT_L(0); PG8_MMA(1, 0, At, B0); PG8_BAR; PG8_SCHED;
            PG8_STAGE(PG8_SB(1, 1), b3 + hstep, voffB);
            PG8_WAIT_V(6); PG8_BAR; PG8_MMA(1, 1, At, B1); PG8_BAR;
            }
        }
        if constexpr (ALIGN_EPI) { if (wr == 0) PG8_BAR; }
        bool keep_acc = false;
        if constexpr (Epi::MIDHOOK) { if (cur.kh == 0 && has_next) { E.mid(acc, cur, wr, wc, fr, fq); keep_acc = true; } else { E(acc, cur, wr, wc, fr, fq); } }
        else if constexpr (!Epi::AFTER_DRAIN) { E(acc, cur, wr, wc, fr, fq); S.done(cur); }
        if (!has_next) break;
        if (!keep_acc) {
#pragma unroll
        for (int a = 0; a < 2; ++a)
#pragma unroll
            for (int b = 0; b < 2; ++b)
#pragma unroll
                for (int m = 0; m < 4; ++m)
#pragma unroll
                    for (int n = 0; n < 2; ++n) acc[a][b][m][n] = (f32x4){0.f, 0.f, 0.f, 0.f};
        }
        cur = nxt; cA = nA; cB = nB; ++ui;
        if constexpr (ALIGN_EPI) { if (wr == 1) PG8_BAR; }
    }
    PG8_WAIT_V(0);
    if constexpr (!ALIGN_EPI) { if (wr == 0) PG8_BAR; }
    PG8_BAR;
    if constexpr (Epi::AFTER_DRAIN) { E.fused(acc, cur, wr, wc, fr, fq, lds, wid, lane); S.done(cur); }
#undef PG8_SA
#undef PG8_SB
#undef PG8_STAGE
#undef PG8_LDA
#undef PG8_LDB
#undef PG8_MMA
#undef PG8_WAIT_V
#undef PG8_WAIT_L
#undef PG8_BAR
#undef PG8_SCHED
}
}
namespace pg8 {
__device__ __forceinline__ float sigm(float x) { return __builtin_amdgcn_rcpf(1.0f + __builtin_amdgcn_exp2f(x * -1.4426950408889634f)); }
__device__ __forceinline__ f32x4 sigm4(f32x4 x) { return (f32x4){sigm(x[0]), sigm(x[1]), sigm(x[2]), sigm(x[3])}; }
__device__ __forceinline__ u32x4 pack8(f32x4 a, f32x4 b) { u32x4 w; w.x = cvt_pk_bf16(a[0], a[1]); w.y = cvt_pk_bf16(a[2], a[3]); w.z = cvt_pk_bf16(b[0], b[1]); w.w = cvt_pk_bf16(b[2], b[3]); return w; }
__device__ __forceinline__ void unpack8(u32x4 w, f32x4& a, f32x4& b) {
    a = (f32x4){__uint_as_float(w.x << 16), __uint_as_float(w.x & 0xffff0000u), __uint_as_float(w.y << 16), __uint_as_float(w.y & 0xffff0000u)};
    b = (f32x4){__uint_as_float(w.z << 16), __uint_as_float(w.z & 0xffff0000u), __uint_as_float(w.w << 16), __uint_as_float(w.w & 0xffff0000u)}; }

struct EpiStore {
    static constexpr bool PERM = true, AFTER_DRAIN = false, MIDHOOK = false;
    bf16_t* O; int ldc;
    __device__ __forceinline__ void operator()(const f32x4 (&acc)[2][2][4][2], const Unit& u, int wr, int wc, int fr, int fq) const {
        const int row0 = u.pm * BM + wr * 64 + fr, col0 = u.pn * BM + wc * 32 + 8 * fq;
#pragma unroll
        for (int ai = 0; ai < 2; ++ai)
#pragma unroll
            for (int m = 0; m < 4; ++m) { bf16_t* rowp = O + (size_t)(row0 + ai * HALF + m * 16) * ldc + col0;
#pragma unroll
                for (int bj = 0; bj < 2; ++bj) *(u32x4*)(rowp + bj * HALF) = pack8(acc[ai][bj][m][0], acc[ai][bj][m][1]); }
    }
};
struct EpiSwiGLU {
    static constexpr bool PERM = true, AFTER_DRAIN = false, MIDHOOK = false;
    bf16_t* O; int ldc;
    __device__ __forceinline__ void operator()(const f32x4 (&acc)[2][2][4][2], const Unit& u, int wr, int wc, int fr, int fq) const {
        const int row0 = u.pm * BM + wr * 64 + fr, col0 = u.pn * HALF + wc * 32 + 8 * fq;
#pragma unroll
        for (int ai = 0; ai < 2; ++ai)
#pragma unroll
            for (int m = 0; m < 4; ++m) { bf16_t* rowp = O + (size_t)(row0 + ai * HALF + m * 16) * ldc + col0;
                const f32x4 g0 = acc[ai][0][m][0], g1 = acc[ai][0][m][1], u0 = acc[ai][1][m][0], u1 = acc[ai][1][m][1];
                const f32x4 h0 = g0 * sigm4(g0) * u0, h1 = g1 * sigm4(g1) * u1;
                *(u32x4*)rowp = pack8(h0, h1); }
    }
};
struct EpiMix {
    static constexpr bool PERM = true, AFTER_DRAIN = false, MIDHOOK = false;
    bf16_t* Q; bf16_t* K; bf16_t* C; bf16_t* G; const float* glu_bias; const float* gate_bias; float qscale;
    __device__ __forceinline__ void operator()(const f32x4 (&acc)[2][2][4][2], const Unit& u, int wr, int wc, int fr, int fq) const {
        const int row0 = u.pm * BM + wr * 64 + fr; const int pn = u.pn;
        if (pn < 4) {
            bf16_t* base = pn < 2 ? Q : K; const float sc = pn < 2 ? qscale : 1.0f; const int col0 = (pn & 1) * BM + wc * 32 + 8 * fq;
#pragma unroll
            for (int ai = 0; ai < 2; ++ai)
#pragma unroll
                for (int m = 0; m < 4; ++m) { bf16_t* rowp = base + (size_t)(row0 + ai * HALF + m * 16) * 512 + col0;
#pragma unroll
                    for (int bj = 0; bj < 2; ++bj) *(u32x4*)(rowp + bj * HALF) = pack8(acc[ai][bj][m][0] * sc, acc[ai][bj][m][1] * sc); }
        } else if (pn < 8) {
            const int col0 = (pn - 4) * HALF + wc * 32 + 8 * fq;
            const f32x4 ba0 = *(const f32x4*)(glu_bias + col0), ba1 = *(const f32x4*)(glu_bias + col0 + 4), bg0 = *(const f32x4*)(glu_bias + 512 + col0), bg1 = *(const f32x4*)(glu_bias + 512 + col0 + 4);
#pragma unroll
            for (int ai = 0; ai < 2; ++ai)
#pragma unroll
                for (int m = 0; m < 4; ++m) { bf16_t* rowp = C + (size_t)(row0 + ai * HALF + m * 16) * 512 + col0;
                    const f32x4 a0 = acc[ai][0][m][0] + ba0, a1 = acc[ai][0][m][1] + ba1, g0 = acc[ai][1][m][0] + bg0, g1 = acc[ai][1][m][1] + bg1;
                    *(u32x4*)rowp = pack8(a0 * sigm4(g0), a1 * sigm4(g1)); }
        } else {
            const int col0 = (pn - 8) * BM + wc * 32 + 8 * fq;
#pragma unroll
            for (int bj = 0; bj < 2; ++bj) { const f32x4 b0 = *(const f32x4*)(gate_bias + col0 + bj * HALF), b1 = *(const f32x4*)(gate_bias + col0 + bj * HALF + 4);
#pragma unroll
                for (int ai = 0; ai < 2; ++ai)
#pragma unroll
                    for (int m = 0; m < 4; ++m) { bf16_t* rowp = G + (size_t)(row0 + ai * HALF + m * 16) * 2048 + col0 + bj * HALF;
                        *(u32x4*)rowp = pack8(sigm4(acc[ai][bj][m][0] + b0), sigm4(acc[ai][bj][m][1] + b1)); } }
        }
    }
};
struct EpiGateMid {
    static constexpr bool PERM = true, AFTER_DRAIN = false, MIDHOOK = true;
    bf16_t* O; const bf16_t* G;
    __device__ __forceinline__ void mid(f32x4 (&acc)[2][2][4][2], const Unit& u, int wr, int wc, int fr, int fq) const {
        const int row0 = u.pm * BM + wr * 64 + fr, col0 = u.pn * BM + wc * 32 + 8 * fq;
#pragma unroll
        for (int ai = 0; ai < 2; ++ai)
#pragma unroll
            for (int m = 0; m < 4; ++m) { const bf16_t* gp = G + (size_t)(row0 + ai * HALF + m * 16) * 2048 + col0;
#pragma unroll
                for (int bj = 0; bj < 2; ++bj) { f32x4 a0, a1, b0, b1; unpack8(*(const u32x4*)(gp + bj * HALF), a0, a1); unpack8(*(const u32x4*)(gp + 1024 + bj * HALF), b0, b1);
#pragma unroll
                    for (int i = 0; i < 4; ++i) { acc[ai][bj][m][0][i] *= a0[i] * __builtin_amdgcn_rcpf(fmaxf(b0[i], 1e-30f)); acc[ai][bj][m][1][i] *= a1[i] * __builtin_amdgcn_rcpf(fmaxf(b1[i], 1e-30f)); } } }
    }
    __device__ __forceinline__ void operator()(const f32x4 (&acc)[2][2][4][2], const Unit& u, int wr, int wc, int fr, int fq) const {
        const int row0 = u.pm * BM + wr * 64 + fr, col0 = u.pn * BM + wc * 32 + 8 * fq;
#pragma unroll
        for (int ai = 0; ai < 2; ++ai)
#pragma unroll
            for (int m = 0; m < 4; ++m) { const size_t r = (size_t)(row0 + ai * HALF + m * 16); bf16_t* rowp = O + r * 1024 + col0; const bf16_t* gp = G + r * 2048 + 1024 + col0;
#pragma unroll
                for (int bj = 0; bj < 2; ++bj) { f32x4 g0, g1; unpack8(*(const u32x4*)(gp + bj * HALF), g0, g1);
                    *(u32x4*)(rowp + bj * HALF) = pack8(acc[ai][bj][m][0] * g0, acc[ai][bj][m][1] * g1); } }
    }
};
}
#define LAS __attribute__((address_space(3)))
#define XB_TMO      128
#define XB_XCNT(j)  (256  + 64 * (j))
#define XB_XSUB(j)  (1280 + 64 * (j))
#define XB_XGEN(j)  (2304 + 64 * (j))
#define XB_TOP      3328
#define XB_TOPGEN   3392
#define XCD_BAR_WORDS 3456
#define XB_SPIN_CAP (1u << 18)

__device__ __forceinline__ unsigned xb_ld(unsigned* p)              { return __hip_atomic_load(p, __ATOMIC_RELAXED, __HIP_MEMORY_SCOPE_AGENT); }
__device__ __forceinline__ unsigned xb_add(unsigned* p, unsigned v) { return __hip_atomic_fetch_add(p, v, __ATOMIC_RELAXED, __HIP_MEMORY_SCOPE_AGENT); }
__device__ __forceinline__ unsigned xb_xcc_id() { return (unsigned)__builtin_amdgcn_s_getreg((3 << 11) | 20) & 0xFu; }
#define XB_SPIN(cond, bar) do { unsigned _sp = 0; while (cond) { __builtin_amdgcn_s_sleep(1); \
    if ((++_sp & 255u) == 0u) { if (xb_ld(&(bar)[XB_TMO])) break; if (_sp > XB_SPIN_CAP) { atomicAdd(&(bar)[XB_TMO], 1u); break; } } } } while (0)

struct XcdBarrier {
    unsigned* bar; unsigned x;
    volatile LAS unsigned* st;
};

__device__ __forceinline__ XcdBarrier xcd_barrier_post(unsigned* bar, volatile LAS unsigned* st) {
    XcdBarrier b; b.bar = bar; b.x = xb_xcc_id(); b.st = st;
    if (threadIdx.x == 0) (void)xb_add(&bar[XB_XCNT(b.x)], 1u);
    return b;
}
__device__ __forceinline__ void xcd_barrier_complete(unsigned* bar, unsigned x, unsigned& nloc, unsigned& nx) {
    const unsigned G = gridDim.x * gridDim.y * gridDim.z;
    unsigned sum, cnt, mine, sp = 0u;
    for (;;) {
        sum = 0u; cnt = 0u; mine = 0u;
#pragma unroll
        for (unsigned j = 0; j < 16; ++j) { const unsigned c = xb_ld(&bar[XB_XCNT(j)]); sum += c; cnt += (c > 0u) ? 1u : 0u; mine = (j == x) ? c : mine; }
        if (sum == G) break;
        __builtin_amdgcn_s_sleep(1);
        if ((++sp & 255u) == 0u) { if (xb_ld(&bar[XB_TMO])) break; if (sp > XB_SPIN_CAP) { atomicAdd(&bar[XB_TMO], 1u); break; } }
    }
    nloc = mine > 0u ? mine : 1u; nx = cnt > 0u ? cnt : 1u;
}

__device__ __forceinline__ void xcd_barrier(const XcdBarrier& b) {
    asm volatile("s_waitcnt vmcnt(0)" ::: "memory");
    __syncthreads();
    if (threadIdx.x == 0) {
        unsigned* bar = b.bar;
        __builtin_amdgcn_s_waitcnt(0);
        unsigned nloc = b.st[0], nx = b.st[1];
        if (nloc == 0u) { xcd_barrier_complete(bar, b.x, nloc, nx); b.st[0] = nloc; b.st[1] = nx; }
        const unsigned old = xb_add(&bar[XB_XSUB(b.x)], 1u);
        const unsigned gen = old / nloc;
        if (old + 1u == (gen + 1u) * nloc) {
            __builtin_amdgcn_fence(__ATOMIC_RELEASE, "agent");
            asm volatile("s_waitcnt vmcnt(0)" ::: "memory");
            const unsigned og = xb_add(&bar[XB_TOP], 1u);
            const unsigned tg = og / nx;
            if (og + 1u == (tg + 1u) * nx) xb_add(&bar[XB_TOPGEN], 1u);
            else XB_SPIN(xb_ld(&bar[XB_TOPGEN]) == tg, bar);
            __builtin_amdgcn_fence(__ATOMIC_ACQUIRE, "agent");
            xb_add(&bar[XB_XGEN(b.x)], 1u);
            asm volatile("s_waitcnt vmcnt(0)" ::: "memory");
        } else {
            XB_SPIN(xb_ld(&bar[XB_XGEN(b.x)]) == gen, bar);
            __builtin_amdgcn_fence(__ATOMIC_ACQUIRE, "agent");
            asm volatile("s_waitcnt vmcnt(0)" ::: "memory");
        }
    }
    __syncthreads();
}

#ifndef MK_N_LAUNCHES
#define MK_N_LAUNCHES 1
#endif
constexpr int NWAVES = 8;
constexpr int BATCH = 4, SEQ = 8192, D = 1024, FF = 2816, DA = 512, DC = 512, NH = 8, HD = 64;
constexpr int M = BATCH * SEQ;
constexpr int NGU = 2 * FF;
constexpr int NMIX = 4096;
constexpr float EPS = 1e-6f;
constexpr float LOG2E = 1.4426950408889634f;
constexpr float QSCALE = 0.125f * LOG2E;

constexpr size_t MiB = 1u << 20;
constexpr size_t WS_WGU1 = 2 * MiB;
constexpr size_t WS_WD1 = WS_WGU1 + (size_t)NGU * D * 2;
constexpr size_t WS_WGU2 = WS_WD1 + (size_t)D * FF * 2;
constexpr size_t WS_WD2 = WS_WGU2 + (size_t)NGU * D * 2;
constexpr size_t WS_WMIX = WS_WD2 + (size_t)D * FF * 2;
constexpr size_t WS_WV = WS_WMIX + (size_t)NMIX * D * 2;
constexpr size_t WS_WAO = WS_WV + (size_t)DA * D * 2;
constexpr size_t WS_WCO = WS_WAO + (size_t)D * DA * 2;
constexpr size_t WS_WOUT = WS_WCO + (size_t)D * DC * 2;
constexpr size_t WS_WEND = WS_WOUT + (size_t)D * D * 2;
static_assert(WS_WEND <= 50 * MiB, "weights");
constexpr size_t WS_XN = 50 * MiB;
constexpr size_t WS_F = 114 * MiB;
constexpr size_t WS_H = 178 * MiB;
constexpr size_t WS_BIG = 306 * MiB;
constexpr size_t WS_Q = WS_BIG, WS_K = WS_BIG + 32 * MiB, WS_VT = WS_BIG + 64 * MiB, WS_C = WS_BIG + 96 * MiB, WS_O = WS_BIG + 128 * MiB, WS_CB = WS_BIG + 160 * MiB;
constexpr size_t WS_END = 512 * MiB;
static_assert(WS_BIG + (size_t)M * FF * 2 <= WS_END && WS_CB + 32 * MiB <= WS_END, "d_ws map");

constexpr int RING_BYTES = 131072;
constexpr int LDS_BYTES = 147456;

typedef unsigned short bf16;
typedef unsigned v4u __attribute__((ext_vector_type(4)));
typedef unsigned v2u __attribute__((ext_vector_type(2)));
typedef float f32x4 __attribute__((ext_vector_type(4)));
typedef float f32x2 __attribute__((ext_vector_type(2)));
typedef float f32x16 __attribute__((ext_vector_type(16)));
typedef short bf16x8 __attribute__((ext_vector_type(8)));
typedef short s16x4 __attribute__((ext_vector_type(4)));
typedef __bf16 bf16x2_t __attribute__((ext_vector_type(2)));
#define LDS_WAIT() asm volatile("s_waitcnt lgkmcnt(0)" ::: "memory")
__device__ __forceinline__ unsigned pk2(float lo, float hi) { f32x2 v = {lo, hi}; bf16x2_t b = __builtin_convertvector(v, bf16x2_t); return __builtin_bit_cast(unsigned, b); }
__device__ __forceinline__ float bf_lo(unsigned u) { return __uint_as_float(u << 16); }
__device__ __forceinline__ float bf_hi(unsigned u) { return __uint_as_float(u & 0xffff0000u); }
__device__ __forceinline__ float wave_sum(float v) {
#pragma unroll
    for (int o = 1; o < 64; o <<= 1) v += __shfl_xor(v, o);
    return v;
}

__device__ __forceinline__ void p0_transpose_item(const float* W, int N, int k0, int n0, bf16* dst, int Kd, LAS float* scr, int lane) {
#pragma unroll 8
    for (int i = 0; i < 32; ++i) { const int kk = 2 * i + (lane >> 5); scr[kk * 33 + (lane & 31)] = W[(size_t)(k0 + kk) * N + n0 + (lane & 31)]; }
    LDS_WAIT(); asm volatile("" ::: "memory");
    const int c = lane & 7;
#pragma unroll
    for (int j = 0; j < 4; ++j) { const int n = (lane >> 3) + 8 * j; const LAS float* s = scr + (8 * c) * 33 + n;
        v4u o; o.x = pk2(s[0 * 33], s[1 * 33]); o.y = pk2(s[2 * 33], s[3 * 33]); o.z = pk2(s[4 * 33], s[5 * 33]); o.w = pk2(s[6 * 33], s[7 * 33]);
        *(v4u*)(dst + (size_t)n * Kd + k0 + 8 * c) = o; }
    LDS_WAIT(); asm volatile("" ::: "memory");
}
__device__ __forceinline__ void rms_row_to_bf16(const float* xrow, const float* g, bf16* orow, int lane) {
    const f32x4* xr = (const f32x4*)xrow + lane; const f32x4* gr = (const f32x4*)g + lane;
    f32x4 v[4]; float s = 0.f;
#pragma unroll
    for (int j = 0; j < 4; ++j) { v[j] = xr[64 * j]; s += (v[j].x * v[j].x + v[j].y * v[j].y) + (v[j].z * v[j].z + v[j].w * v[j].w); }
    const float rs = 1.0f / sqrtf(wave_sum(s) * (1.f / D) + EPS);
    v2u* o8 = (v2u*)orow + lane;
#pragma unroll
    for (int j = 0; j < 4; ++j) { const f32x4 gg = gr[64 * j]; v2u o; o.x = pk2(v[j].x * rs * gg.x, v[j].y * rs * gg.y); o.y = pk2(v[j].z * rs * gg.z, v[j].w * rs * gg.w); o8[64 * j] = o; }
}
struct WPtrs { const float *g1, *u1, *d1, *g2, *u2, *d2, *win, *wao, *wco, *wout; };
__device__ __forceinline__ void p0_prologue(LAS unsigned char* lds, const WPtrs& P, unsigned char* ws, const float* x, const float* gpre, int G, int bid, int wave, int lane) {
    LAS float* scr = (LAS float*)(lds + wave * 16384);
    const int gw = bid * NWAVES + wave, NGW = G * NWAVES;
    constexpr int I_GU = (D / 64) * (FF / 32), I_DN = (FF / 64) * (D / 32), I_IN = (D / 64) * (4608 / 32), I_AO = (DA / 64) * (D / 32), I_WO = (D / 64) * (D / 32);
    constexpr int NITEMS = 4 * I_GU + 2 * I_DN + I_IN + 2 * I_AO + I_WO;
    bf16* XN = (bf16*)(ws + WS_XN);
    for (int m = gw; m < M; m += NGW) rms_row_to_bf16(x + (size_t)m * D, gpre, XN + (size_t)m * D, lane);
    for (int it = gw; it < NITEMS; it += NGW) {
        int r = it;
        if (r < 4 * I_GU) {
            const int which = r / I_GU; r -= which * I_GU; const int nblk = FF / 32, kb = r / nblk, nb = r % nblk, n0 = 32 * nb;
            const float* W = which == 0 ? P.g1 : which == 1 ? P.u1 : which == 2 ? P.g2 : P.u2;
            bf16* WT = (bf16*)(ws + (which < 2 ? WS_WGU1 : WS_WGU2));
            const int drow = 256 * (n0 >> 7) + 128 * (which & 1) + (n0 & 127);
            p0_transpose_item(W, FF, 64 * kb, n0, WT + (size_t)drow * D, D, scr, lane); continue; }
        r -= 4 * I_GU;
        if (r < 2 * I_DN) {
            const int which = r / I_DN; r -= which * I_DN; const int nblk = D / 32, kb = r / nblk, nb = r % nblk, n0 = 32 * nb;
            p0_transpose_item(which == 0 ? P.d1 : P.d2, D, 64 * kb, n0, (bf16*)(ws + (which == 0 ? WS_WD1 : WS_WD2)) + (size_t)n0 * FF, FF, scr, lane); continue; }
        r -= 2 * I_DN;
        if (r < I_IN) {
            const int nblk = 4608 / 32, kb = r / nblk, nb = r % nblk, n0 = 32 * nb;
            bf16* dst;
            if (n0 < 1024) dst = (bf16*)(ws + WS_WMIX) + (size_t)n0 * D;
            else if (n0 < 1536) dst = (bf16*)(ws + WS_WV) + (size_t)(n0 - 1024) * D;
            else if (n0 < 2048) { const int c = n0 - 1536; dst = (bf16*)(ws + WS_WMIX) + (size_t)(1024 + 256 * (c >> 7) + (c & 127)) * D; }
            else if (n0 < 2560) { const int c = n0 - 2048; dst = (bf16*)(ws + WS_WMIX) + (size_t)(1024 + 256 * (c >> 7) + 128 + (c & 127)) * D; }
            else dst = (bf16*)(ws + WS_WMIX) + (size_t)(2048 + (n0 - 2560)) * D;
            p0_transpose_item(P.win, 4608, 64 * kb, n0, dst, D, scr, lane); continue; }
        r -= I_IN;
        if (r < 2 * I_AO) {
            const int which = r / I_AO; r -= which * I_AO; const int nblk = D / 32, kb = r / nblk, nb = r % nblk, n0 = 32 * nb;
            p0_transpose_item(which == 0 ? P.wao : P.wco, D, 64 * kb, n0, (bf16*)(ws + WS_WAO) + (size_t)n0 * D + which * DA, D, scr, lane); continue; }
        r -= 2 * I_AO;
        { const int nblk = D / 32, kb = r / nblk, nb = r % nblk, n0 = 32 * nb;
          p0_transpose_item(P.wout, D, 64 * kb, n0, (bf16*)(ws + WS_WOUT) + (size_t)n0 * D, D, scr, lane); }
    }
}

template <bool BASE_BF16, bool OUT_BF16>
__device__ __forceinline__ void row_pass(const void* base, const bf16* f, const float* gpost, float scale, void* hout, const float* gnext, bf16* xn, int G, int bid, int wave, int lane) {
    const int gw = bid * NWAVES + wave, NGW = G * NWAVES;
    const f32x4* gp = (const f32x4*)gpost + lane; const f32x4* gn = (const f32x4*)gnext + lane;
    for (int m0 = gw; m0 < M; m0 += 2 * NGW) {
        f32x4 fv[2][4], bv[2][4]; float s[2];
#pragma unroll
        for (int q = 0; q < 2; ++q) { const int m = m0 + q * NGW; if (m < M) {
            const v2u* fr = (const v2u*)(f + (size_t)m * D) + lane;
#pragma unroll
            for (int j = 0; j < 4; ++j) { const v2u w = fr[64 * j]; fv[q][j] = (f32x4){bf_lo(w.x), bf_hi(w.x), bf_lo(w.y), bf_hi(w.y)}; }
            if (BASE_BF16) { const v2u* br = (const v2u*)((const bf16*)base + (size_t)m * D) + lane;
#pragma unroll
                for (int j = 0; j < 4; ++j) { const v2u w = br[64 * j]; bv[q][j] = (f32x4){bf_lo(w.x), bf_hi(w.x), bf_lo(w.y), bf_hi(w.y)}; } }
            else { const f32x4* br = (const f32x4*)((const float*)base + (size_t)m * D) + lane;
#pragma unroll
                for (int j = 0; j < 4; ++j) bv[q][j] = br[64 * j]; } } }
#pragma unroll
        for (int q = 0; q < 2; ++q) { s[q] = 0.f;
#pragma unroll
            for (int j = 0; j < 4; ++j) s[q] += (fv[q][j].x * fv[q][j].x + fv[q][j].y * fv[q][j].y) + (fv[q][j].z * fv[q][j].z + fv[q][j].w * fv[q][j].w); }
#pragma unroll
        for (int o = 1; o < 64; o <<= 1) { s[0] += __shfl_xor(s[0], o); s[1] += __shfl_xor(s[1], o); }
        float s2[2];
#pragma unroll
        for (int q = 0; q < 2; ++q) { const int m = m0 + q * NGW; const float rs = scale / sqrtf(s[q] * (1.f / D) + EPS); s2[q] = 0.f;
#pragma unroll
            for (int j = 0; j < 4; ++j) { const f32x4 gg = gp[64 * j]; bv[q][j] = bv[q][j] + fv[q][j] * rs * gg; }
            if (m < M) {
                if (OUT_BF16) { v2u* ho = (v2u*)((bf16*)hout + (size_t)m * D) + lane;
#pragma unroll
                    for (int j = 0; j < 4; ++j) { v2u o; o.x = pk2(bv[q][j].x, bv[q][j].y); o.y = pk2(bv[q][j].z, bv[q][j].w); ho[64 * j] = o;
                        bv[q][j] = (f32x4){bf_lo(o.x), bf_hi(o.x), bf_lo(o.y), bf_hi(o.y)}; } }
                else { f32x4* ho = (f32x4*)((float*)hout + (size_t)m * D) + lane;
#pragma unroll
                    for (int j = 0; j < 4; ++j) ho[64 * j] = bv[q][j]; } }
#pragma unroll
            for (int j = 0; j < 4; ++j) s2[q] += (bv[q][j].x * bv[q][j].x + bv[q][j].y * bv[q][j].y) + (bv[q][j].z * bv[q][j].z + bv[q][j].w * bv[q][j].w); }
        if (gnext) {
#pragma unroll
            for (int o = 1; o < 64; o <<= 1) { s2[0] += __shfl_xor(s2[0], o); s2[1] += __shfl_xor(s2[1], o); }
#pragma unroll
            for (int q = 0; q < 2; ++q) { const int m = m0 + q * NGW; if (m < M) { const float rs2 = 1.0f / sqrtf(s2[q] * (1.f / D) + EPS);
                v2u* o8 = (v2u*)(xn + (size_t)m * D) + lane;
#pragma unroll
                for (int j = 0; j < 4; ++j) { const f32x4 gg = gn[64 * j]; v2u o; o.x = pk2(bv[q][j].x * rs2 * gg.x, bv[q][j].y * rs2 * gg.y); o.y = pk2(bv[q][j].z * rs2 * gg.z, bv[q][j].w * rs2 * gg.w); o8[64 * j] = o; } } }
        }
    }
}

__device__ __forceinline__ int crow(int r, int hi) { return (r & 3) + 8 * (r >> 2) + 4 * hi; }
#define MFMA32(a, b, c) __builtin_amdgcn_mfma_f32_32x32x16_bf16((a), (b), (c), 0, 0, 0)
__device__ __forceinline__ void attn_phase(LAS unsigned char* lds, const bf16* Q, const bf16* Kb, const bf16* Vt, bf16* O, const float* rel_table, int G, int bid) {
    const int tid = threadIdx.x, lane = tid & 63, r = lane & 31, hi = lane >> 5; const int w = __builtin_amdgcn_readfirstlane(tid >> 6);
    constexpr int PITCH = 144, TILE = 64 * PITCH;
    LAS unsigned char* Ks = lds; LAS unsigned char* Vs = lds + 2 * TILE; LAS float* tbl = (LAS float*)(lds + 4 * TILE);
    const int srow = tid >> 3, sc = tid & 7, soff = srow * PITCH + sc * 16;
    for (int u = bid; u < BATCH * NH * 32; u += G) {
        const int cg4 = u & 31, h = (u >> 5) & 7, b = u >> 8;
        const int c0 = cg4 * 4, c = c0 + (w >> 1);
        const int kt_first = c0 - 8 > 0 ? c0 - 8 : 0, kt_last = c0 + 3;
        const size_t tokb = (size_t)b * SEQ;
        if (tid < 257) tbl[tid] = (rel_table[h * 257 + tid] - rel_table[h * 257 + 256]) * LOG2E;
        const int qpos = c * 64 + 32 * (w & 1) + r;
        bf16x8 qf[4];
        { const bf16* qp = Q + (tokb + qpos) * DA + h * HD + 8 * hi;
#pragma unroll
          for (int d0 = 0; d0 < 4; ++d0) qf[d0] = *(const bf16x8*)(qp + 16 * d0); }
        f32x16 o0, o1;
#pragma unroll
        for (int i = 0; i < 16; ++i) { o0[i] = 0.f; o1[i] = 0.f; }
        float mrow = 0.f, lsum = 0.f; f32x16 negm;
#pragma unroll
        for (int i = 0; i < 16; ++i) negm[i] = 0.f;
        const bf16* kg = Kb + (tokb + srow) * DA + h * HD + sc * 8;
        const bf16* vg = Vt + (size_t)(h * HD + srow) * M + tokb + sc * 8;
        v4u kregA = *(const v4u*)(kg + (size_t)kt_first * 64 * DA), vregA = *(const v4u*)(vg + kt_first * 64);
        v4u kregB = *(const v4u*)(kg + (size_t)(kt_first + 1) * 64 * DA), vregB = *(const v4u*)(vg + (kt_first + 1) * 64);
        *(LAS v4u*)(Ks + soff) = kregA; *(LAS v4u*)(Vs + soff) = vregA;
        __syncthreads();
        int cur = 0;
        for (int kt2 = kt_first; kt2 <= kt_last; kt2 += 2) {
#pragma unroll
          for (int hf = 0; hf < 2; ++hf) {
            const int kt = kt2 + hf;
            if (kt + 2 <= kt_last) {
                if (hf == 0) { kregA = *(const v4u*)(kg + (size_t)(kt + 2) * 64 * DA); vregA = *(const v4u*)(vg + (kt + 2) * 64); }
                else { kregB = *(const v4u*)(kg + (size_t)(kt + 2) * 64 * DA); vregB = *(const v4u*)(vg + (kt + 2) * 64); } }
            if (kt >= c - 8 && kt <= c) {
                const LAS unsigned char* kb = Ks + cur * TILE + r * PITCH + hi * 16;
                const bool nearT = kt >= c - 2;
                const bool first = kt == (c - 8 > 0 ? c - 8 : 0);
                f32x16 p0, p1;
#pragma unroll
                for (int d0 = 0; d0 < 4; ++d0) {
                    const bf16x8 k0 = *(const LAS bf16x8*)(kb + d0 * 32), k1 = *(const LAS bf16x8*)(kb + 32 * PITCH + d0 * 32);
                    if (d0 == 0) { p0 = MFMA32(k0, qf[0], negm); p1 = MFMA32(k1, qf[0], negm); }
                    else { p0 = MFMA32(k0, qf[d0], p0); p1 = MFMA32(k1, qf[d0], p1); } }
                if (nearT) {
                    const int dbase = qpos - kt * 64 - 4 * hi;
#pragma unroll
                    for (int i = 0; i < 16; ++i) { int d_ = dbase - ((i & 3) + 8 * (i >> 2));
                        int i0 = d_ < -128 ? -128 : (d_ > 128 ? 128 : d_); int d1 = d_ - 32; int i1 = d1 < -128 ? -128 : (d1 > 128 ? 128 : d1);
                        p0[i] += tbl[i0 + 128]; p1[i] += tbl[i1 + 128]; }
                }
                float mx = fmaxf(fmaxf(p0[0], p0[1]), p1[0]);
#pragma unroll
                for (int i = 2; i < 16; i += 2) mx = fmaxf(fmaxf(mx, p0[i]), p0[i + 1]);
#pragma unroll
                for (int i = 1; i < 15; i += 2) mx = fmaxf(fmaxf(mx, p1[i]), p1[i + 1]);
                mx = fmaxf(mx, p1[15]);
                mx = fmaxf(mx, __shfl_xor(mx, 32));
                if (first || __any(mx > 8.0f)) {
                    const float delta = first ? mx : fmaxf(mx, 0.f);
#pragma unroll
                    for (int i = 0; i < 16; ++i) { p0[i] -= delta; p1[i] -= delta; }
                    mrow += delta;
#pragma unroll
                    for (int i = 0; i < 16; ++i) negm[i] = -mrow;
                    if (!first) { const float fsc = __builtin_amdgcn_exp2f(-delta); lsum *= fsc;
#pragma unroll
                        for (int i = 0; i < 16; ++i) { o0[i] *= fsc; o1[i] *= fsc; } }
                }
                float ps = 0.f;
#pragma unroll
                for (int i = 0; i < 16; ++i) { p0[i] = __builtin_amdgcn_exp2f(p0[i]); p1[i] = __builtin_amdgcn_exp2f(p1[i]); ps += p0[i] + p1[i]; }
                lsum += ps;
                bf16x8 pf[4];
                { v4u t;
                  t.x = pk2(p0[0], p0[1]); t.y = pk2(p0[2], p0[3]); t.z = pk2(p0[4], p0[5]); t.w = pk2(p0[6], p0[7]); pf[0] = __builtin_bit_cast(bf16x8, t);
                  t.x = pk2(p0[8], p0[9]); t.y = pk2(p0[10], p0[11]); t.z = pk2(p0[12], p0[13]); t.w = pk2(p0[14], p0[15]); pf[1] = __builtin_bit_cast(bf16x8, t);
                  t.x = pk2(p1[0], p1[1]); t.y = pk2(p1[2], p1[3]); t.z = pk2(p1[4], p1[5]); t.w = pk2(p1[6], p1[7]); pf[2] = __builtin_bit_cast(bf16x8, t);
                  t.x = pk2(p1[8], p1[9]); t.y = pk2(p1[10], p1[11]); t.z = pk2(p1[12], p1[13]); t.w = pk2(p1[14], p1[15]); pf[3] = __builtin_bit_cast(bf16x8, t); }
                const LAS unsigned char* vb = Vs + cur * TILE + r * PITCH + hi * 8;
#pragma unroll
                for (int s = 0; s < 4; ++s) {
                    const int kvb = ((s >> 1) * 32 + (s & 1) * 16) * 2;
                    const s16x4 a0 = *(const LAS s16x4*)(vb + kvb), a1 = *(const LAS s16x4*)(vb + kvb + 16);
                    const s16x4 b0 = *(const LAS s16x4*)(vb + 32 * PITCH + kvb), b1 = *(const LAS s16x4*)(vb + 32 * PITCH + kvb + 16);
                    const bf16x8 va = __builtin_shufflevector(a0, a1, 0, 1, 2, 3, 4, 5, 6, 7), vbb = __builtin_shufflevector(b0, b1, 0, 1, 2, 3, 4, 5, 6, 7);
                    o0 = MFMA32(va, pf[s], o0); o1 = MFMA32(vbb, pf[s], o1); }
            }
            if (kt + 1 <= kt_last) {
                if (hf == 0) { *(LAS v4u*)(Ks + (cur ^ 1) * TILE + soff) = kregB; *(LAS v4u*)(Vs + (cur ^ 1) * TILE + soff) = vregB; }
                else { *(LAS v4u*)(Ks + (cur ^ 1) * TILE + soff) = kregA; *(LAS v4u*)(Vs + (cur ^ 1) * TILE + soff) = vregA; } }
            __syncthreads();
            cur ^= 1;
          }
        }
        lsum += __shfl_xor(lsum, 32);
        const float inv = 1.0f / lsum;
        bf16* op = O + (tokb + qpos) * D + h * HD + 4 * hi;
#pragma unroll
        for (int g = 0; g < 4; ++g) {
            v2u a; a.x = pk2(o0[4 * g] * inv, o0[4 * g + 1] * inv); a.y = pk2(o0[4 * g + 2] * inv, o0[4 * g + 3] * inv); *(v2u*)(op + 8 * g) = a;
            v2u bb; bb.x = pk2(o1[4 * g] * inv, o1[4 * g + 1] * inv); bb.y = pk2(o1[4 * g + 2] * inv, o1[4 * g + 3] * inv); *(v2u*)(op + 32 + 8 * g) = bb; }
    }
}

__device__ __forceinline__ void conv_phase(LAS unsigned char* lds, const bf16* Cin, const float* dw_w, const float* dw_b, const float* ln_g, const float* ln_b, bf16* CB, int G, int bid) {
    const int tid = threadIdx.x, lane = tid & 63; const int w = __builtin_amdgcn_readfirstlane(tid >> 6);
    LAS unsigned char* tin = lds; LAS float* tout = (LAS float*)(lds + 62 * 1024);
    const int cp = tid & 255, rh = tid >> 8;
    for (int u = bid; u < M / 32; u += G) {
        const int t0 = u * 32, s0 = t0 & (SEQ - 1);
        { v4u tv[8];
#pragma unroll
          for (int i = 0; i < 8; ++i) { const int p = tid + 512 * i, row = p >> 6, c16 = p & 63; tv[i] = (v4u){0u, 0u, 0u, 0u};
              if (p < 62 * 64 && s0 - 30 + row >= 0) tv[i] = *(const v4u*)(Cin + (size_t)(t0 - 30 + row) * DC + c16 * 8); }
#pragma unroll
          for (int i = 0; i < 8; ++i) { const int p = tid + 512 * i, row = p >> 6, c16 = p & 63;
              if (p < 62 * 64) *(LAS v4u*)(tin + row * 1024 + c16 * 16) = tv[i]; } }
        __syncthreads();
        { f32x2 in[46];
#pragma unroll
          for (int i = 0; i < 46; ++i) { const unsigned v = *(const LAS unsigned*)(tin + (16 * rh + i) * 1024 + cp * 4); in[i] = (f32x2){bf_lo(v), bf_hi(v)}; }
          f32x2 acc[16];
          { const f32x2 bb = *(const f32x2*)(dw_b + 2 * cp);
#pragma unroll
            for (int t = 0; t < 16; ++t) acc[t] = bb; }
#pragma unroll
          for (int j = 0; j < 31; ++j) { const f32x2 ww = *(const f32x2*)(dw_w + j * DC + 2 * cp);
#pragma unroll
              for (int t = 0; t < 16; ++t) acc[t] += ww * in[t + j]; }
#pragma unroll
          for (int t = 0; t < 16; ++t) *(LAS f32x2*)(tout + (16 * rh + t) * DC + 2 * cp) = acc[t]; }
        __syncthreads();
        const f32x4 g0 = *(const f32x4*)(ln_g + lane * 8), g1 = *(const f32x4*)(ln_g + lane * 8 + 4), b0 = *(const f32x4*)(ln_b + lane * 8), b1 = *(const f32x4*)(ln_b + lane * 8 + 4);
#pragma unroll
        for (int rr = 0; rr < 4; ++rr) { const int row = 4 * w + rr;
            f32x4 v0 = *(const LAS f32x4*)(tout + row * DC + lane * 8), v1 = *(const LAS f32x4*)(tout + row * DC + lane * 8 + 4);
            const float mean = wave_sum((v0.x + v0.y) + (v0.z + v0.w) + (v1.x + v1.y) + (v1.z + v1.w)) * (1.f / DC);
            v0 = v0 - mean; v1 = v1 - mean;
            const float var = wave_sum((v0.x * v0.x + v0.y * v0.y) + (v0.z * v0.z + v0.w * v0.w) + (v1.x * v1.x + v1.y * v1.y) + (v1.z * v1.z + v1.w * v1.w)) * (1.f / DC);
            const float rstd = 1.0f / sqrtf(var + EPS);
            v0 = v0 * rstd * g0 + b0; v1 = v1 * rstd * g1 + b1;
            v0 = v0 * pg8::sigm4(v0); v1 = v1 * pg8::sigm4(v1);
            v4u o; o.x = pk2(v0.x, v0.y); o.y = pk2(v0.z, v0.w); o.z = pk2(v1.x, v1.y); o.w = pk2(v1.z, v1.w);
            *(v4u*)(CB + (size_t)(t0 + row) * D + DC + lane * 8) = o; }
        __syncthreads();
    }
}

struct Args { const float* in[24]; float* out; unsigned char* ws; int ph_lo, ph_hi; };
__global__ void __launch_bounds__(NWAVES * 64, 2) mega_fwd(Args a) {
    extern __shared__ __attribute__((aligned(16))) unsigned char lds_raw[];
    cg::grid_group grid = cg::this_grid();
    LAS unsigned char* lds = (LAS unsigned char*)lds_raw;
    const int tid = threadIdx.x, lane = tid & 63, wave = __builtin_amdgcn_readfirstlane(tid >> 6);
    const int G = gridDim.x, bid = blockIdx.x;
    unsigned char* ws = a.ws;
    bf16* XN = (bf16*)(ws + WS_XN); bf16* F = (bf16*)(ws + WS_F); bf16* H = (bf16*)(ws + WS_H); bf16* HB = (bf16*)(ws + WS_BIG);
    bf16* Qb = (bf16*)(ws + WS_Q); bf16* Kb = (bf16*)(ws + WS_K); bf16* Vt = (bf16*)(ws + WS_VT); bf16* Cb = (bf16*)(ws + WS_C); bf16* Ob = (bf16*)(ws + WS_O); bf16* CBb = Ob;
    bf16* MERGED = XN;
    bf16* GT = (bf16*)a.out;
    const float* x = a.in[0];
    volatile LAS unsigned* MISC = (volatile LAS unsigned*)(lds + RING_BYTES);
    if (tid < 16) MISC[tid] = 0u;
    if (bid == 0) {
        for (int i = tid; i < 4096; i += NWAVES * 64) ((unsigned*)ws)[i] = 0u;
        asm volatile("s_waitcnt vmcnt(0)" ::: "memory"); __builtin_amdgcn_fence(__ATOMIC_RELEASE, "agent"); asm volatile("s_waitcnt vmcnt(0)" ::: "memory");
    }
    __syncthreads();
    grid.sync();
    XcdBarrier bar = xcd_barrier_post((unsigned*)ws, MISC + 8);
#define GRID_SYNC() xcd_barrier(bar)

    if (a.ph_lo <= 0 && 0 < a.ph_hi) {
    { WPtrs P{a.in[2], a.in[3], a.in[4], a.in[20], a.in[21], a.in[22], a.in[7], a.in[10], a.in[16], a.in[17]};
      p0_prologue(lds, P, ws, x, a.in[1], G, bid, wave, lane); }
    if (a.ph_lo <= 0 && 1 < a.ph_hi) GRID_SYNC();
    }
    if (a.ph_lo <= 1 && 1 < a.ph_hi) {
    { pg8::Gemm g{XN, (const bf16*)(ws + WS_WGU1), M, NGU, D, D}; pg8::StaticOrder S; S.init(M, NGU, G, bid);
      pg8::EpiSwiGLU E{HB, FF}; pg8::gemm_phase<pg8::EpiSwiGLU, pg8::StaticOrder, true, true>(lds, g, S, E); }
    if (a.ph_lo <= 1 && 2 < a.ph_hi) GRID_SYNC();
    }
    if (a.ph_lo <= 2 && 2 < a.ph_hi) {
    { pg8::Gemm g{HB, (const bf16*)(ws + WS_WD1), M, D, FF, FF}; pg8::StaticOrder S; S.init(M, D, G, bid);
      pg8::EpiStore E{F, D}; pg8::gemm_phase<pg8::EpiStore, pg8::StaticOrder, true, true>(lds, g, S, E); }
    if (a.ph_lo <= 2 && 3 < a.ph_hi) GRID_SYNC();
    }
    if (a.ph_lo <= 3 && 3 < a.ph_hi) {
    row_pass<false, true>(x, F, a.in[5], 0.5f, H, a.in[6], XN, G, bid, wave, lane);
    if (a.ph_lo <= 3 && 4 < a.ph_hi) GRID_SYNC();
    }
    if (a.ph_lo <= 4 && 4 < a.ph_hi) {
    { pg8::Gemm g{XN, (const bf16*)(ws + WS_WMIX), M, NMIX, D, D}; pg8::StaticOrder S; S.init(M, NMIX, G, bid);
      pg8::EpiMix E{Qb, Kb, Cb, GT, a.in[11], a.in[8], QSCALE}; pg8::gemm_phase<pg8::EpiMix, pg8::StaticOrder, true, true>(lds, g, S, E); }
    { pg8::Gemm g{(const bf16*)(ws + WS_WV), XN, DA, M, D, D}; pg8::StaticOrder S; S.init(DA, M, G, bid);
      pg8::EpiStore E{Vt, M}; pg8::gemm_phase<pg8::EpiStore, pg8::StaticOrder, true, true>(lds, g, S, E); }
    if (a.ph_lo <= 4 && 5 < a.ph_hi) GRID_SYNC();
    }
    if (a.ph_lo <= 5 && 5 < a.ph_hi) {
    attn_phase(lds, Qb, Kb, Vt, Ob, a.in[9], G, bid);
    conv_phase(lds, Cb, a.in[12], a.in[13], a.in[14], a.in[15], CBb, G, bid);
    if (a.ph_lo <= 5 && 6 < a.ph_hi) GRID_SYNC();
    }
    if (a.ph_lo <= 6 && 6 < a.ph_hi) {
    { pg8::Gemm g{Ob, (const bf16*)(ws + WS_WAO), M, D, DA, D}; pg8::HalfOrder S; S.init(M, D, G, bid);
      pg8::EpiGateMid E{MERGED, GT}; pg8::gemm_phase<pg8::EpiGateMid, pg8::HalfOrder, true, true>(lds, g, S, E); }
    if (a.ph_lo <= 6 && 7 < a.ph_hi) GRID_SYNC();
    }
    if (a.ph_lo <= 7 && 7 < a.ph_hi) {
    { pg8::Gemm g{MERGED, (const bf16*)(ws + WS_WOUT), M, D, D, D}; pg8::StaticOrder S; S.init(M, D, G, bid);
      pg8::EpiStore E{F, D}; pg8::gemm_phase<pg8::EpiStore, pg8::StaticOrder, true, true>(lds, g, S, E); }
    if (a.ph_lo <= 7 && 8 < a.ph_hi) GRID_SYNC();
    }
    if (a.ph_lo <= 8 && 8 < a.ph_hi) {
    row_pass<true, true>(H, F, a.in[18], 1.0f, H, a.in[19], XN, G, bid, wave, lane);
    if (a.ph_lo <= 8 && 9 < a.ph_hi) GRID_SYNC();
    }
    if (a.ph_lo <= 9 && 9 < a.ph_hi) {
    { pg8::Gemm g{XN, (const bf16*)(ws + WS_WGU2), M, NGU, D, D}; pg8::StaticOrder S; S.init(M, NGU, G, bid);
      pg8::EpiSwiGLU E{HB, FF}; pg8::gemm_phase<pg8::EpiSwiGLU, pg8::StaticOrder, true, true>(lds, g, S, E); }
    if (a.ph_lo <= 9 && 10 < a.ph_hi) GRID_SYNC();
    }
    if (a.ph_lo <= 10 && 10 < a.ph_hi) {
    { pg8::Gemm g{HB, (const bf16*)(ws + WS_WD2), M, D, FF, FF}; pg8::StaticOrder S; S.init(M, D, G, bid);
      pg8::EpiStore E{F, D}; pg8::gemm_phase<pg8::EpiStore, pg8::StaticOrder, true, true>(lds, g, S, E); }
    if (a.ph_lo <= 10 && 11 < a.ph_hi) GRID_SYNC();
    }
    if (a.ph_lo <= 11 && 11 < a.ph_hi) {
    row_pass<true, false>(H, F, a.in[23], 0.5f, a.out, nullptr, nullptr, G, bid, wave, lane);
    }
#ifdef DBG_END
    if (a.ph_lo == 99) {
        const int gw = bid * NWAVES + wave, NGW = G * NWAVES;
        if (DBG_END == 55) { for (int m = gw; m < M; m += NGW) { float* o = a.out + (size_t)m * D; float v[16];
#pragma unroll
            for (int j = 0; j < 16; ++j) v[j] = bf_lo(GT[(size_t)m * 2048 + lane + 64 * j]) + bf_lo(GT[(size_t)m * 2048 + 1024 + lane + 64 * j]);
            asm volatile("s_waitcnt vmcnt(0)" ::: "memory");
#pragma unroll
            for (int j = 0; j < 16; ++j) o[lane + 64 * j] = v[j]; } }
        else for (int m = gw; m < M; m += NGW) { float* o = a.out + (size_t)m * D;
            for (int j = lane; j < D; j += 64) {
                float v;
                if (DBG_END <= 4) v = bf_lo(H[(size_t)m * D + j]);
                else if (DBG_END == 5) v = j < 512 ? bf_lo(Qb[(size_t)m * 512 + j]) + bf_lo(Kb[(size_t)m * 512 + j]) : bf_lo(Cb[(size_t)m * 512 + j - 512]) + bf_lo(Vt[(size_t)(j - 512) * M + m]);
                else if (DBG_END == 6) v = bf_lo(Ob[(size_t)m * D + j]);
                else if (DBG_END == 7) v = bf_lo(MERGED[(size_t)m * D + j]);
                else v = bf_lo(F[(size_t)m * D + j]);
                o[j] = v; } }
    }
#endif
}

extern "C" void kernel_launch(void* const* d_in, const int* in_sizes, int n_in, void* d_out, int out_size, void* d_ws, size_t ws_size, hipStream_t stream) {
    static int grid = 0;
    if (grid == 0) {
        if (n_in != 24 || in_sizes[0] != M * D || out_size != M * D || ws_size < WS_END) { fprintf(stderr, "kernel_launch: unexpected shapes (n_in %d, in0 %d, out %d, ws %zu); nothing launched\n", n_in, n_in > 0 ? in_sizes[0] : -1, out_size, ws_size); grid = -1; return; }
        int dev = 0, cus = 0, per_cu = 0;
        if (hipGetDevice(&dev) != hipSuccess || hipDeviceGetAttribute(&cus, hipDeviceAttributeMultiprocessorCount, dev) != hipSuccess) { grid = -1; return; }
        if (hipFuncSetAttribute((const void*)mega_fwd, hipFuncAttributeMaxDynamicSharedMemorySize, LDS_BYTES) != hipSuccess) { fprintf(stderr, "kernel_launch: hipFuncSetAttribute failed\n"); grid = -1; return; }
        if (hipOccupancyMaxActiveBlocksPerMultiprocessor(&per_cu, (const void*)mega_fwd, NWAVES * 64, LDS_BYTES) != hipSuccess || per_cu < 1) { fprintf(stderr, "kernel_launch: occupancy query reports %d blocks per CU\n", per_cu); (void)hipGetLastError(); grid = -1; return; }
        grid = cus;
    }
    if (grid < 0) return;
    Args a{};
    for (int i = 0; i < 24; ++i) a.in[i] = (const float*)d_in[i];
    a.out = (float*)d_out; a.ws = (unsigned char*)d_ws;
    void* args[] = {&a};
#if MK_N_LAUNCHES == 1
    a.ph_lo = 0; a.ph_hi = 12;
    hipError_t e = hipLaunchCooperativeKernel((const void*)mega_fwd, dim3(grid), dim3(NWAVES * 64), args, LDS_BYTES, stream);
    if (e != hipSuccess) fprintf(stderr, "kernel_launch: cooperative launch failed: %s (grid %d)\n", hipGetErrorString(e), grid);
#else
#ifdef DBG_END
    for (int p = 0; p < (DBG_END == 55 ? 5 : DBG_END); ++p) { a.ph_lo = p; a.ph_hi = p + 1; hipLaunchKernelGGL(mega_fwd, dim3(grid), dim3(NWAVES * 64), LDS_BYTES, stream, a); }
    a.ph_lo = 99; a.ph_hi = 100; hipLaunchKernelGGL(mega_fwd, dim3(grid), dim3(NWAVES * 64), LDS_BYTES, stream, a);
#else
    for (int p = 0; p < 12; ++p) { a.ph_lo = p; a.ph_hi = p + 1; hipLaunchKernelGGL(mega_fwd, dim3(grid), dim3(NWAVES * 64), LDS_BYTES, stream, a); }
#endif
#endif
}
```

```cpp
#include <hip/hip_runtime.h>
#include <hip/hip_cooperative_groups.h>
#include <cstdio>
#include <cstdint>
namespace cg = cooperative_groups;
namespace pg8 {
#define PG8_LAS __attribute__((address_space(3)))
typedef unsigned short bf16_t;
typedef short bf16x8 __attribute__((ext_vector_type(8)));
typedef float f32x4 __attribute__((ext_vector_type(4)));
typedef unsigned u32x4 __attribute__((ext_vector_type(4)));
constexpr int BM = 256, BK = 64, HALF = 128, HTB = HALF * BK * 2  , STAGE_BYTES = 8 * HTB, NXCD = 8, WGM = 4;

__host__ __device__ __forceinline__ int lds_byte(int r, int c) { const int st = (r >> 4) * 2 + (c >> 5), rr = r & 15, cc = c & 31, ob = rr * 64 + cc * 2; return st * 1024 + (ob ^ (((ob >> 9) & 1) << 5)); }
__host__ __device__ __forceinline__ void stage_rc(int b, int& R, int& C) { const int st = b / 1024, sb = b % 1024, swz = sb ^ (((sb >> 9) & 1) << 5); R = (st >> 1) * 16 + swz / 64; C = (st & 1) * 32 + (swz % 64) / 2; }
__host__ __device__ __forceinline__ int perm32(int rho) { const int n = rho >> 4, i = rho & 15; return 8 * (i >> 2) + 4 * n + (i & 3); }

struct Unit { int pm, pn, kh; };
struct Gemm { const bf16_t* A; const bf16_t* Bt; int M, N, K, ld; };

struct StaticOrder {
    int nM, nN, nwg, G, c;
    __host__ __device__ void init(int M, int N, int G_, int c_) { nM = M / BM; nN = N / BM; nwg = nM * nN; G = G_; c = c_; }
    __host__ __device__ bool next(int i, Unit& u) const {
        const long L = (long)i * G + c; if (L >= nwg) return false;
        int wgid = (int)L; { const int q = nwg / NXCD, r = nwg % NXCD, xcd = wgid % NXCD, off = wgid / NXCD; wgid = (xcd < r ? xcd * (q + 1) : r * (q + 1) + (xcd - r) * q) + off; }
        const int nig = WGM * nN, gid = wgid / nig, fm = gid * WGM, gsz = (nM - fm) < WGM ? (nM - fm) : WGM;
        u.pm = fm + ((wgid % nig) % gsz); u.pn = (wgid % nig) / gsz; u.kh = 0; return true;
    }
    __device__ __forceinline__ void a_ready(const Unit&) const {}
    __device__ __forceinline__ void done(const Unit&) const {}
};

struct HalfOrder {
    StaticOrder so;
    __host__ __device__ void init(int M, int N, int G_, int c_) { so.init(M, N, G_, c_); }
    __host__ __device__ bool next(int i, Unit& u) const { if (!so.next(i >> 1, u)) return false; u.kh = i & 1; return true; }
    __device__ __forceinline__ void a_ready(const Unit&) const {}
    __device__ __forceinline__ void done(const Unit&) const {}
};
typedef float f32x2 __attribute__((ext_vector_type(2)));
typedef __bf16 bf16x2v __attribute__((ext_vector_type(2)));
__device__ __forceinline__ unsigned cvt_pk_bf16(float lo, float hi) { f32x2 v = {lo, hi}; bf16x2v b = __builtin_convertvector(v, bf16x2v); return __builtin_bit_cast(unsigned, b); }
template <class Epi, class Sched, bool ALIGN_EPI = false, bool SP2 = false>
__device__ __forceinline__ void gemm_phase(PG8_LAS unsigned char* lds, const Gemm g, const Sched& S, const Epi& E) {
    const int tid = threadIdx.x, wid = __builtin_amdgcn_readfirstlane(tid >> 6), lane = tid & 63, wr = wid >> 2, wc = wid & 3, fr = lane & 15, fq = lane >> 4;
    const int K = g.ld, nt = g.K / BK;
    unsigned voffA[2], voffB[2];
#pragma unroll
    for (int i = 0; i < 2; ++i) { int R, C; stage_rc(tid * 16 + i * 8192, R, C); const int Rb = Epi::PERM ? ((R & ~31) + perm32(R & 31)) : R;
        voffA[i] = (unsigned)(R * K + C) * 2u; voffB[i] = (unsigned)(Rb * K + C) * 2u; }
    const size_t kstep = (size_t)(BK * 2);
    const size_t hstep = (size_t)HALF * K * 2;
    const size_t tstep = 2 * hstep;
    const unsigned ldsw = (unsigned)wid * 1024u;
    const int aoff = lds_byte(wr * 64 + fr, fq * 8), boff = lds_byte(wc * 32 + fr, fq * 8);
#define PG8_SA(b, h) (((b) * 2 + (h)) * HTB)
#define PG8_SB(b, h) ((4 + (b) * 2 + (h)) * HTB)
#define PG8_STAGE(bufoff, gbase, voff) do { _Pragma("unroll") for (int _i = 0; _i < 2; ++_i) \
        __builtin_amdgcn_global_load_lds((const unsigned*)((const char*)(gbase) + (voff)[_i]), (PG8_LAS unsigned*)(lds + (bufoff) + ldsw + _i * 8192), 16, 0, 0); } while (0)
#define PG8_LDA(dst, b, h) do { _Pragma("unroll") for (int m = 0; m < 4; ++m) _Pragma("unroll") for (int k = 0; k < 2; ++k) dst[m][k] = *(const PG8_LAS bf16x8*)(lds + PG8_SA(b, h) + aoff + m * 2048 + k * 1024); } while (0)
#define PG8_LDB(dst, b, h) do { _Pragma("unroll") for (int n = 0; n < 2; ++n) _Pragma("unroll") for (int k = 0; k < 2; ++k) dst[n][k] = *(const PG8_LAS bf16x8*)(lds + PG8_SB(b, h) + boff + n * 2048 + k * 1024); } while (0)
#define PG8_MMA(ai, bj, At, Bt) do { __builtin_amdgcn_s_setprio(1); _Pragma("unroll") for (int m = 0; m < 4; ++m) _Pragma("unroll") for (int n = 0; n < 2; ++n) _Pragma("unroll") for (int k = 0; k < 2; ++k) \
        acc[ai][bj][m][n] = __builtin_amdgcn_mfma_f32_16x16x32_bf16(Bt[n][k], At[m][k], acc[ai][bj][m][n], 0, 0, 0); __builtin_amdgcn_s_setprio(0); } while (0)
#define PG8_WAIT_V(n) asm volatile("s_waitcnt vmcnt(" #n ")" ::: "memory")
#define PG8_WAIT_L(n) asm volatile("s_waitcnt lgkmcnt(" #n ")" ::: "memory")
#define PG8_BAR __builtin_amdgcn_s_barrier()
#define PG8_SCHED __builtin_amdgcn_sched_barrier(0)
    Unit cur, nxt; int ui = 0;
    if (!S.next(0, cur)) return;
    f32x4 acc[2][2][4][2];
#pragma unroll
    for (int a = 0; a < 2; ++a)
#pragma unroll
        for (int b = 0; b < 2; ++b)
#pragma unroll
            for (int m = 0; m < 4; ++m)
#pragma unroll
                for (int n = 0; n < 2; ++n) acc[a][b][m][n] = (f32x4){0.f, 0.f, 0.f, 0.f};
    bf16x8 At[4][2], B0[2][2], B1[2][2];
    const size_t khstep = (size_t)g.K * 2;
    const char* cA = (const char*)g.A + (size_t)cur.pm * tstep + cur.kh * khstep; const char* cB = (const char*)g.Bt + (size_t)cur.pn * tstep + cur.kh * khstep;
    S.a_ready(cur);
    if constexpr (SP2) {
        PG8_STAGE(PG8_SB(0, 0), cB, voffB); PG8_STAGE(PG8_SB(0, 1), cB + hstep, voffB); PG8_STAGE(PG8_SA(0, 0), cA, voffA); PG8_STAGE(PG8_SA(0, 1), cA + hstep, voffA);
        if (wr == 1) PG8_BAR;
        PG8_WAIT_V(2); PG8_BAR;
        PG8_STAGE(PG8_SB(1, 0), cB + kstep, voffB); PG8_STAGE(PG8_SA(1, 0), cA + kstep, voffA); PG8_STAGE(PG8_SB(1, 1), cB + hstep + kstep, voffB);
        PG8_WAIT_V(6); PG8_BAR;
    } else {
        PG8_STAGE(PG8_SB(0, 0), cB, voffB); PG8_STAGE(PG8_SA(0, 0), cA, voffA); PG8_STAGE(PG8_SB(0, 1), cB + hstep, voffB); PG8_STAGE(PG8_SA(0, 1), cA + hstep, voffA);
        if (wr == 1) PG8_BAR;
        PG8_WAIT_V(4); PG8_BAR;
        PG8_STAGE(PG8_SB(1, 0), cB + kstep, voffB); PG8_STAGE(PG8_SA(1, 0), cA + kstep, voffA); PG8_STAGE(PG8_SB(1, 1), cB + hstep + kstep, voffB);
        PG8_WAIT_V(6); PG8_BAR;
    }
    for (;;) {
        const bool has_next = S.next(ui + 1, nxt);
        const char* nA = has_next ? (const char*)g.A + (size_t)nxt.pm * tstep + nxt.kh * khstep : cA; const char* nB = has_next ? (const char*)g.Bt + (size_t)nxt.pn * tstep + nxt.kh * khstep : cB;
        for (int t = 0; t < nt; t += 2) {
            const bool last = (t == nt - 2);
            const char* a1 = cA + (size_t)(t + 1) * kstep;
            const char* a2 = last ? nA : cA + (size_t)(t + 2) * kstep; const char* b2 = last ? nB : cB + (size_t)(t + 2) * kstep;
            const char* a3 = a2 + kstep; const char* b3 = b2 + kstep;
            if (last && has_next) S.a_ready(nxt);
            if constexpr (SP2) {
            PG8_LDB(B0, 0, 0); PG8_LDB(B1, 0, 1); PG8_SCHED; PG8_LDA(At, 0, 0); PG8_STAGE(PG8_SA(1, 1), a1 + hstep, voffA);
            PG8_WAIT_V(8); PG8_WAIT_L(0); PG8_BAR; PG8_MMA(0, 0, At, B0); PG8_MMA(0, 1, At, B1); PG8_BAR; PG8_SCHED;
            PG8_LDA(At, 0, 1); PG8_STAGE(PG8_SB(0, 0), b2, voffB); PG8_STAGE(PG8_SB(0, 1), b2 + hstep, voffB); PG8_STAGE(PG8_SA(0, 0), a2, voffA);
            PG8_WAIT_V(8); PG8_WAIT_L(0); PG8_BAR; PG8_MMA(1, 0, At, B0); PG8_MMA(1, 1, At, B1); PG8_BAR; PG8_SCHED;
            PG8_LDB(B0, 1, 0); PG8_LDB(B1, 1, 1); PG8_SCHED; PG8_LDA(At, 1, 0); PG8_STAGE(PG8_SA(0, 1), a2 + hstep, voffA);
            PG8_WAIT_V(8); PG8_WAIT_L(0); PG8_BAR; PG8_MMA(0, 0, At, B0); PG8_MMA(0, 1, At, B1); PG8_BAR; PG8_SCHED;
            PG8_LDA(At, 1, 1); PG8_STAGE(PG8_SB(1, 0), b3, voffB); PG8_STAGE(PG8_SB(1, 1), b3 + hstep, voffB); PG8_STAGE(PG8_SA(1, 0), a3, voffA);
            PG8_WAIT_V(8); PG8_WAIT_L(0); PG8_BAR; PG8_MMA(1, 0, At, B0); PG8_MMA(1, 1, At, B1); PG8_BAR; PG8_SCHED;
            } else {
            PG8_LDB(B0, 0, 0); PG8_SCHED; PG8_LDA(At, 0, 0); PG8_STAGE(PG8_SA(1, 1), a1 + hstep, voffA);
            PG8_WAIT_L(8); PG8_BAR; PG8_WAIT_L(0); PG8_MMA(0, 0, At, B0); PG8_BAR; PG8_SCHED;
            PG8_LDB(B1, 0, 1); PG8_STAGE(PG8_SB(0, 0), b2, voffB);
            PG8_BAR; PG8_WAIT_L(0); PG8_MMA(0, 1, At, B1); PG8_BAR;
            PG8_LDA(At, 0, 1); PG8_STAGE(PG8_SA(0, 0), a2, voffA);
            PG8_BAR; PG8_WAIT_L(0); PG8_MMA(1, 0, At, B0); PG8_BAR; PG8_SCHED;
            PG8_STAGE(PG8_SB(0, 1), b2 + hstep, voffB);
            PG8_WAIT_V(6); PG8_BAR; PG8_MMA(1, 1, At, B1); PG8_BAR;
            PG8_LDB(B0, 1, 0); PG8_SCHED; PG8_LDA(At, 1, 0); PG8_STAGE(PG8_SA(0, 1), a2 + hstep, voffA);
            PG8_WAIT_L(8); PG8_BAR; PG8_WAIT_L(0); PG8_MMA(0, 0, At, B0); PG8_BAR; PG8_SCHED;
            PG8_LDB(B1, 1, 1); PG8_STAGE(PG8_SB(1, 0), b3, voffB);
            PG8_BAR; PG8_WAIT_L(0); PG8_MMA(0, 1, At, B1); PG8_BAR;
            PG8_LDA(At, 1, 1); PG8_STAGE(PG8_SA(1, 0), a3, voffA);
            PG8_BAR; PG8_WAIT_L(0); PG8_MMA(1, 0, At, B0); PG8_BAR; PG8_SCHED;
            PG8_STAGE(PG8_SB(1, 1), b3 + hstep, voffB);
            PG8_WAIT_V(6); PG8_BAR; PG8_MMA(1, 1, At, B1); PG8_BAR;
            }
        }
        if constexpr (ALIGN_EPI) { if (wr == 0) PG8_BAR; }
        bool keep_acc = false;
        if constexpr (Epi::MIDHOOK) { if (cur.kh == 0 && has_next) { E.mid(acc, cur, wr, wc, fr, fq); keep_acc = true; } else { E(acc, cur, wr, wc, fr, fq); } }
        else if constexpr (!Epi::AFTER_DRAIN) { E(acc, cur, wr, wc, fr, fq); S.done(cur); }
        if (!has_next) break;
        if (!keep_acc) {
#pragma unroll
        for (int a = 0; a < 2; ++a)
#pragma unroll
            for (int b = 0; b < 2; ++b)
#pragma unroll
                for (int m = 0; m < 4; ++m)
#pragma unroll
                    for (int n = 0; n < 2; ++n) acc[a][b][m][n] = (f32x4){0.f, 0.f, 0.f, 0.f};
        }
        cur = nxt; cA = nA; cB = nB; ++ui;
        if constexpr (ALIGN_EPI) { if (wr == 1) PG8_BAR; }
    }
    PG8_WAIT_V(0);
    if constexpr (!ALIGN_EPI) { if (wr == 0) PG8_BAR; }
    PG8_BAR;
    if constexpr (Epi::AFTER_DRAIN) { E.fused(acc, cur, wr, wc, fr, fq, lds, wid, lane); S.done(cur); }
#undef PG8_SA
#undef PG8_SB
#undef PG8_STAGE
#undef PG8_LDA
#undef PG8_LDB
#undef PG8_MMA
#undef PG8_WAIT_V
#undef PG8_WAIT_L
#undef PG8_BAR
#undef PG8_SCHED
}
}
namespace pg8 {
__device__ __forceinline__ float sigm(float x) { return __builtin_amdgcn_rcpf(1.0f + __builtin_amdgcn_exp2f(x * -1.4426950408889634f)); }
__device__ __forceinline__ f32x4 sigm4(f32x4 x) { return (f32x4){sigm(x[0]), sigm(x[1]), sigm(x[2]), sigm(x[3])}; }
__device__ __forceinline__ u32x4 pack8(f32x4 a, f32x4 b) { u32x4 w; w.x = cvt_pk_bf16(a[0], a[1]); w.y = cvt_pk_bf16(a[2], a[3]); w.z = cvt_pk_bf16(b[0], b[1]); w.w = cvt_pk_bf16(b[2], b[3]); return w; }
__device__ __forceinline__ void unpack8(u32x4 w, f32x4& a, f32x4& b) {
    a = (f32x4){__uint_as_float(w.x << 16), __uint_as_float(w.x & 0xffff0000u), __uint_as_float(w.y << 16), __uint_as_float(w.y & 0xffff0000u)};
    b = (f32x4){__uint_as_float(w.z << 16), __uint_as_float(w.z & 0xffff0000u), __uint_as_float(w.w << 16), __uint_as_float(w.w & 0xffff0000u)}; }

struct EpiStore {
    static constexpr bool PERM = true, AFTER_DRAIN = false, MIDHOOK = false;
    bf16_t* O; int ldc;
    __device__ __forceinline__ void operator()(const f32x4 (&acc)[2][2][4][2], const Unit& u, int wr, int wc, int fr, int fq) const {
        const int row0 = u.pm * BM + wr * 64 + fr, col0 = u.pn * BM + wc * 32 + 8 * fq;
#pragma unroll
        for (int ai = 0; ai < 2; ++ai)
#pragma unroll
            for (int m = 0; m < 4; ++m) { bf16_t* rowp = O + (size_t)(row0 + ai * HALF + m * 16) * ldc + col0;
#pragma unroll
                for (int bj = 0; bj < 2; ++bj) *(u32x4*)(rowp + bj * HALF) = pack8(acc[ai][bj][m][0], acc[ai][bj][m][1]); }
    }
};
struct EpiSwiGLU {
    static constexpr bool PERM = true, AFTER_DRAIN = false, MIDHOOK = false;
    bf16_t* O; int ldc;
    __device__ __forceinline__ void operator()(const f32x4 (&acc)[2][2][4][2], const Unit& u, int wr, int wc, int fr, int fq) const {
        const int row0 = u.pm * BM + wr * 64 + fr, col0 = u.pn * HALF + wc * 32 + 8 * fq;
#pragma unroll
        for (int ai = 0; ai < 2; ++ai)
#pragma unroll
            for (int m = 0; m < 4; ++m) { bf16_t* rowp = O + (size_t)(row0 + ai * HALF + m * 16) * ldc + col0;
                const f32x4 g0 = acc[ai][0][m][0], g1 = acc[ai][0][m][1], u0 = acc[ai][1][m][0], u1 = acc[ai][1][m][1];
                const f32x4 h0 = g0 * sigm4(g0) * u0, h1 = g1 * sigm4(g1) * u1;
                *(u32x4*)rowp = pack8(h0, h1); }
    }
};
struct EpiMix {
    static constexpr bool PERM = true, AFTER_DRAIN = false, MIDHOOK = false;
    bf16_t* Q; bf16_t* K; bf16_t* C; bf16_t* G; const float* glu_bias; const float* gate_bias; float qscale;
    __device__ __forceinline__ void operator()(const f32x4 (&acc)[2][2][4][2], const Unit& u, int wr, int wc, int fr, int fq) const {
        const int row0 = u.pm * BM + wr * 64 + fr; const int pn = u.pn;
        if (pn < 4) {
            bf16_t* base = pn < 2 ? Q : K; const float sc = pn < 2 ? qscale : 1.0f; const int col0 = (pn & 1) * BM + wc * 32 + 8 * fq;
#pragma unroll
            for (int ai = 0; ai < 2; ++ai)
#pragma unroll
                for (int m = 0; m < 4; ++m) { bf16_t* rowp = base + (size_t)(row0 + ai * HALF + m * 16) * 512 + col0;
#pragma unroll
                    for (int bj = 0; bj < 2; ++bj) *(u32x4*)(rowp + bj * HALF) = pack8(acc[ai][bj][m][0] * sc, acc[ai][bj][m][1] * sc); }
        } else if (pn < 8) {
            const int col0 = (pn - 4) * HALF + wc * 32 + 8 * fq;
            const f32x4 ba0 = *(const f32x4*)(glu_bias + col0), ba1 = *(const f32x4*)(glu_bias + col0 + 4), bg0 = *(const f32x4*)(glu_bias + 512 + col0), bg1 = *(const f32x4*)(glu_bias + 512 + col0 + 4);
#pragma unroll
            for (int ai = 0; ai < 2; ++ai)
#pragma unroll
                for (int m = 0; m < 4; ++m) { bf16_t* rowp = C + (size_t)(row0 + ai * HALF + m * 16) * 512 + col0;
                    const f32x4 a0 = acc[ai][0][m][0] + ba0, a1 = acc[ai][0][m][1] + ba1, g0 = acc[ai][1][m][0] + bg0, g1 = acc[ai][1][m][1] + bg1;
                    *(u32x4*)rowp = pack8(a0 * sigm4(g0), a1 * sigm4(g1)); }
        } else {
            const int col0 = (pn - 8) * BM + wc * 32 + 8 * fq;
#pragma unroll
            for (int bj = 0; bj < 2; ++bj) { const f32x4 b0 = *(const f32x4*)(gate_bias + col0 + bj * HALF), b1 = *(const f32x4*)(gate_bias + col0 + bj * HALF + 4);
#pragma unroll
                for (int ai = 0; ai < 2; ++ai)
#pragma unroll
                    for (int m = 0; m < 4; ++m) { bf16_t* rowp = G + (size_t)(row0 + ai * HALF + m * 16) * 2048 + col0 + bj * HALF;
                        *(u32x4*)rowp = pack8(sigm4(acc[ai][bj][m][0] + b0), sigm4(acc[ai][bj][m][1] + b1)); } }
        }
    }
};
struct EpiGateMid {
    static constexpr bool PERM = true, AFTER_DRAIN = false, MIDHOOK = true;
    bf16_t* O; const bf16_t* G;
    __device__ __forceinline__ void mid(f32x4 (&acc)[2][2][4][2], const Unit& u, int wr, int wc, int fr, int fq) const {
        const int row0 = u.pm * BM + wr * 64 + fr, col0 = u.pn * BM + wc * 32 + 8 * fq;
#pragma unroll
        for (int ai = 0; ai < 2; ++ai)
#pragma unroll
            for (int m = 0; m < 4; ++m) { const bf16_t* gp = G + (size_t)(row0 + ai * HALF + m * 16) * 2048 + col0;
#pragma unroll
                for (int bj = 0; bj < 2; ++bj) { f32x4 a0, a1, b0, b1; unpack8(*(const u32x4*)(gp + bj * HALF), a0, a1); unpack8(*(const u32x4*)(gp + 1024 + bj * HALF), b0, b1);
#pragma unroll
                    for (int i = 0; i < 4; ++i) { acc[ai][bj][m][0][i] *= a0[i] * __builtin_amdgcn_rcpf(fmaxf(b0[i], 1e-30f)); acc[ai][bj][m][1][i] *= a1[i] * __builtin_amdgcn_rcpf(fmaxf(b1[i], 1e-30f)); } } }
    }
    __device__ __forceinline__ void operator()(const f32x4 (&acc)[2][2][4][2], const Unit& u, int wr, int wc, int fr, int fq) const {
        const int row0 = u.pm * BM + wr * 64 + fr, col0 = u.pn * BM + wc * 32 + 8 * fq;
#pragma unroll
        for (int ai = 0; ai < 2; ++ai)
#pragma unroll
            for (int m = 0; m < 4; ++m) { const size_t r = (size_t)(row0 + ai * HALF + m * 16); bf16_t* rowp = O + r * 1024 + col0; const bf16_t* gp = G + r * 2048 + 1024 + col0;
#pragma unroll
                for (int bj = 0; bj < 2; ++bj) { f32x4 g0, g1; unpack8(*(const u32x4*)(gp + bj * HALF), g0, g1);
                    *(u32x4*)(rowp + bj * HALF) = pack8(acc[ai][bj][m][0] * g0, acc[ai][bj][m][1] * g1); } }
    }
};
}
#define LAS __attribute__((address_space(3)))
#define XB_TMO      128
#define XB_XCNT(j)  (256  + 64 * (j))
#define XB_XSUB(j)  (1280 + 64 * (j))
#define XB_XGEN(j)  (2304 + 64 * (j))
#define XB_TOP      3328
#define XB_TOPGEN   3392
#define XCD_BAR_WORDS 3456
#define XB_SPIN_CAP (1u << 18)

__device__ __forceinline__ unsigned xb_ld(unsigned* p)              { return __hip_atomic_load(p, __ATOMIC_RELAXED, __HIP_MEMORY_SCOPE_AGENT); }
__device__ __forceinline__ unsigned xb_add(unsigned* p, unsigned v) { return __hip_atomic_fetch_add(p, v, __ATOMIC_RELAXED, __HIP_MEMORY_SCOPE_AGENT); }
__device__ __forceinline__ unsigned xb_xcc_id() { return (unsigned)__builtin_amdgcn_s_getreg((3 << 11) | 20) & 0xFu; }
#define XB_SPIN(cond, bar) do { unsigned _sp = 0; while (cond) { __builtin_amdgcn_s_sleep(1); \
    if ((++_sp & 255u) == 0u) { if (xb_ld(&(bar)[XB_TMO])) break; if (_sp > XB_SPIN_CAP) { atomicAdd(&(bar)[XB_TMO], 1u); break; } } } } while (0)

struct XcdBarrier {
    unsigned* bar; unsigned x;
    volatile LAS unsigned* st;
};

__device__ __forceinline__ XcdBarrier xcd_barrier_post(unsigned* bar, volatile LAS unsigned* st) {
    XcdBarrier b; b.bar = bar; b.x = xb_xcc_id(); b.st = st;
    if (threadIdx.x == 0) (void)xb_add(&bar[XB_XCNT(b.x)], 1u);
    return b;
}
__device__ __forceinline__ void xcd_barrier_complete(unsigned* bar, unsigned x, unsigned& nloc, unsigned& nx) {
    const unsigned G = gridDim.x * gridDim.y * gridDim.z;
    unsigned sum, cnt, mine, sp = 0u;
    for (;;) {
        sum = 0u; cnt = 0u; mine = 0u;
#pragma unroll
        for (unsigned j = 0; j < 16; ++j) { const unsigned c = xb_ld(&bar[XB_XCNT(j)]); sum += c; cnt += (c > 0u) ? 1u : 0u; mine = (j == x) ? c : mine; }
        if (sum == G) break;
        __builtin_amdgcn_s_sleep(1);
        if ((++sp & 255u) == 0u) { if (xb_ld(&bar[XB_TMO])) break; if (sp > XB_SPIN_CAP) { atomicAdd(&bar[XB_TMO], 1u); break; } }
    }
    nloc = mine > 0u ? mine : 1u; nx = cnt > 0u ? cnt : 1u;
}

__device__ __forceinline__ void xcd_barrier(const XcdBarrier& b) {
    asm volatile("s_waitcnt vmcnt(0)" ::: "memory");
    __syncthreads();
    if (threadIdx.x == 0) {
        unsigned* bar = b.bar;
        __builtin_amdgcn_s_waitcnt(0);
        unsigned nloc = b.st[0], nx = b.st[1];
        if (nloc == 0u) { xcd_barrier_complete(bar, b.x, nloc, nx); b.st[0] = nloc; b.st[1] = nx; }
        const unsigned old = xb_add(&bar[XB_XSUB(b.x)], 1u);
        const unsigned gen = old / nloc;
        if (old + 1u == (gen + 1u) * nloc) {
            __builtin_amdgcn_fence(__ATOMIC_RELEASE, "agent");
            asm volatile("s_waitcnt vmcnt(0)" ::: "memory");
            const unsigned og = xb_add(&bar[XB_TOP], 1u);
            const unsigned tg = og / nx;
            if (og + 1u == (tg + 1u) * nx) xb_add(&bar[XB_TOPGEN], 1u);
            else XB_SPIN(xb_ld(&bar[XB_TOPGEN]) == tg, bar);
            __builtin_amdgcn_fence(__ATOMIC_ACQUIRE, "agent");
            xb_add(&bar[XB_XGEN(b.x)], 1u);
            asm volatile("s_waitcnt vmcnt(0)" ::: "memory");
        } else {
            XB_SPIN(xb_ld(&bar[XB_XGEN(b.x)]) == gen, bar);
            __builtin_amdgcn_fence(__ATOMIC_ACQUIRE, "agent");
            asm volatile("s_waitcnt vmcnt(0)" ::: "memory");
        }
    }
    __syncthreads();
}

#ifndef MK_N_LAUNCHES
#define MK_N_LAUNCHES 1
#endif
constexpr int NWAVES = 8;
constexpr int BATCH = 4, SEQ = 8192, D = 1024, FF = 2816, DA = 512, DC = 512, NH = 8, HD = 64;
constexpr int M = BATCH * SEQ;
constexpr int NGU = 2 * FF;
constexpr int NMIX = 4096;
constexpr float EPS = 1e-6f;
constexpr float LOG2E = 1.4426950408889634f;
constexpr float QSCALE = 0.125f * LOG2E;

constexpr size_t MiB = 1u << 20;
constexpr size_t WS_WGU1 = 2 * MiB;
constexpr size_t WS_WD1 = WS_WGU1 + (size_t)NGU * D * 2;
constexpr size_t WS_WGU2 = WS_WD1 + (size_t)D * FF * 2;
constexpr size_t WS_WD2 = WS_WGU2 + (size_t)NGU * D * 2;
constexpr size_t WS_WMIX = WS_WD2 + (size_t)D * FF * 2;
constexpr size_t WS_WV = WS_WMIX + (size_t)NMIX * D * 2;
constexpr size_t WS_WAO = WS_WV + (size_t)DA * D * 2;
constexpr size_t WS_WCO = WS_WAO + (size_t)D * DA * 2;
constexpr size_t WS_WOUT = WS_WCO + (size_t)D * DC * 2;
constexpr size_t WS_WEND = WS_WOUT + (size_t)D * D * 2;
static_assert(WS_WEND <= 50 * MiB, "weights");
constexpr size_t WS_XN = 50 * MiB;
constexpr size_t WS_F = 114 * MiB;
constexpr size_t WS_H = 178 * MiB;
constexpr size_t WS_BIG = 306 * MiB;
constexpr size_t WS_Q = WS_BIG, WS_K = WS_BIG + 32 * MiB, WS_VT = WS_BIG + 64 * MiB, WS_C = WS_BIG + 96 * MiB, WS_O = WS_BIG + 128 * MiB, WS_CB = WS_BIG + 160 * MiB;
constexpr size_t WS_END = 512 * MiB;
static_assert(WS_BIG + (size_t)M * FF * 2 <= WS_END && WS_CB + 32 * MiB <= WS_END, "d_ws map");

constexpr int RING_BYTES = 131072;
constexpr int LDS_BYTES = 147456;

typedef unsigned short bf16;
typedef unsigned v4u __attribute__((ext_vector_type(4)));
typedef unsigned v2u __attribute__((ext_vector_type(2)));
typedef float f32x4 __attribute__((ext_vector_type(4)));
typedef float f32x2 __attribute__((ext_vector_type(2)));
typedef float f32x16 __attribute__((ext_vector_type(16)));
typedef short bf16x8 __attribute__((ext_vector_type(8)));
typedef short s16x4 __attribute__((ext_vector_type(4)));
typedef __bf16 bf16x2_t __attribute__((ext_vector_type(2)));
#define LDS_WAIT() asm volatile("s_waitcnt lgkmcnt(0)" ::: "memory")
__device__ __forceinline__ unsigned pk2(float lo, float hi) { f32x2 v = {lo, hi}; bf16x2_t b = __builtin_convertvector(v, bf16x2_t); return __builtin_bit_cast(unsigned, b); }
__device__ __forceinline__ float bf_lo(unsigned u) { return __uint_as_float(u << 16); }
__device__ __forceinline__ float bf_hi(unsigned u) { return __uint_as_float(u & 0xffff0000u); }
__device__ __forceinline__ float wave_sum(float v) {
#pragma unroll
    for (int o = 1; o < 64; o <<= 1) v += __shfl_xor(v, o);
    return v;
}

__device__ __forceinline__ void p0_transpose_item(const float* W, int N, int k0, int n0, bf16* dst, int Kd, LAS float* scr, int lane) {
#pragma unroll 8
    for (int i = 0; i < 32; ++i) { const int kk = 2 * i + (lane >> 5); scr[kk * 33 + (lane & 31)] = W[(size_t)(k0 + kk) * N + n0 + (lane & 31)]; }
    LDS_WAIT(); asm volatile("" ::: "memory");
    const int c = lane & 7;
#pragma unroll
    for (int j = 0; j < 4; ++j) { const int n = (lane >> 3) + 8 * j; const LAS float* s = scr + (8 * c) * 33 + n;
        v4u o; o.x = pk2(s[0 * 33], s[1 * 33]); o.y = pk2(s[2 * 33], s[3 * 33]); o.z = pk2(s[4 * 33], s[5 * 33]); o.w = pk2(s[6 * 33], s[7 * 33]);
        *(v4u*)(dst + (size_t)n * Kd + k0 + 8 * c) = o; }
    LDS_WAIT(); asm volatile("" ::: "memory");
}
__device__ __forceinline__ void rms_row_to_bf16(const float* xrow, const float* g, bf16* orow, int lane) {
    const f32x4* xr = (const f32x4*)xrow + lane; const f32x4* gr = (const f32x4*)g + lane;
    f32x4 v[4]; float s = 0.f;
#pragma unroll
    for (int j = 0; j < 4; ++j) { v[j] = xr[64 * j]; s += (v[j].x * v[j].x + v[j].y * v[j].y) + (v[j].z * v[j].z + v[j].w * v[j].w); }
    const float rs = 1.0f / sqrtf(wave_sum(s) * (1.f / D) + EPS);
    v2u* o8 = (v2u*)orow + lane;
#pragma unroll
    for (int j = 0; j < 4; ++j) { const f32x4 gg = gr[64 * j]; v2u o; o.x = pk2(v[j].x * rs * gg.x, v[j].y * rs * gg.y); o.y = pk2(v[j].z * rs * gg.z, v[j].w * rs * gg.w); o8[64 * j] = o; }
}
struct WPtrs { const float *g1, *u1, *d1, *g2, *u2, *d2, *win, *wao, *wco, *wout; };
__device__ __forceinline__ void p0_prologue(LAS unsigned char* lds, const WPtrs& P, unsigned char* ws, const float* x, const float* gpre, int G, int bid, int wave, int lane) {
    LAS float* scr = (LAS float*)(lds + wave * 16384);
    const int gw = bid * NWAVES + wave, NGW = G * NWAVES;
    constexpr int I_GU = (D / 64) * (FF / 32), I_DN = (FF / 64) * (D / 32), I_IN = (D / 64) * (4608 / 32), I_AO = (DA / 64) * (D / 32), I_WO = (D / 64) * (D / 32);
    constexpr int NITEMS = 4 * I_GU + 2 * I_DN + I_IN + 2 * I_AO + I_WO;
    bf16* XN = (bf16*)(ws + WS_XN);
    for (int m = gw; m < M; m += NGW) rms_row_to_bf16(x + (size_t)m * D, gpre, XN + (size_t)m * D, lane);
    for (int it = gw; it < NITEMS; it += NGW) {
        int r = it;
        if (r < 4 * I_GU) {
            const int which = r / I_GU; r -= which * I_GU; const int nblk = FF / 32, kb = r / nblk, nb = r % nblk, n0 = 32 * nb;
            const float* W = which == 0 ? P.g1 : which == 1 ? P.u1 : which == 2 ? P.g2 : P.u2;
            bf16* WT = (bf16*)(ws + (which < 2 ? WS_WGU1 : WS_WGU2));
            const int drow = 256 * (n0 >> 7) + 128 * (which & 1) + (n0 & 127);
            p0_transpose_item(W, FF, 64 * kb, n0, WT + (size_t)drow * D, D, scr, lane); continue; }
        r -= 4 * I_GU;
        if (r < 2 * I_DN) {
            const int which = r / I_DN; r -= which * I_DN; const int nblk = D / 32, kb = r / nblk, nb = r % nblk, n0 = 32 * nb;
            p0_transpose_item(which == 0 ? P.d1 : P.d2, D, 64 * kb, n0, (bf16*)(ws + (which == 0 ? WS_WD1 : WS_WD2)) + (size_t)n0 * FF, FF, scr, lane); continue; }
        r -= 2 * I_DN;
        if (r < I_IN) {
            const int nblk = 4608 / 32, kb = r / nblk, nb = r % nblk, n0 = 32 * nb;
            bf16* dst;
            if (n0 < 1024) dst = (bf16*)(ws + WS_WMIX) + (size_t)n0 * D;
            else if (n0 < 1536) dst = (bf16*)(ws + WS_WV) + (size_t)(n0 - 1024) * D;
            else if (n0 < 2048) { const int c = n0 - 1536; dst = (bf16*)(ws + WS_WMIX) + (size_t)(1024 + 256 * (c >> 7) + (c & 127)) * D; }
            else if (n0 < 2560) { const int c = n0 - 2048; dst = (bf16*)(ws + WS_WMIX) + (size_t)(1024 + 256 * (c >> 7) + 128 + (c & 127)) * D; }
            else dst = (bf16*)(ws + WS_WMIX) + (size_t)(2048 + (n0 - 2560)) * D;
            p0_transpose_item(P.win, 4608, 64 * kb, n0, dst, D, scr, lane); continue; }
        r -= I_IN;
        if (r < 2 * I_AO) {
            const int which = r / I_AO; r -= which * I_AO; const int nblk = D / 32, kb = r / nblk, nb = r % nblk, n0 = 32 * nb;
            p0_transpose_item(which == 0 ? P.wao : P.wco, D, 64 * kb, n0, (bf16*)(ws + WS_WAO) + (size_t)n0 * D + which * DA, D, scr, lane); continue; }
        r -= 2 * I_AO;
        { const int nblk = D / 32, kb = r / nblk, nb = r % nblk, n0 = 32 * nb;
          p0_transpose_item(P.wout, D, 64 * kb, n0, (bf16*)(ws + WS_WOUT) + (size_t)n0 * D, D, scr, lane); }
    }
}

template <bool BASE_BF16, bool OUT_BF16>
__device__ __forceinline__ void row_pass(const void* base, const bf16* f, const float* gpost, float scale, void* hout, const float* gnext, bf16* xn, int G, int bid, int wave, int lane) {
    const int gw = bid * NWAVES + wave, NGW = G * NWAVES;
    const f32x4* gp = (const f32x4*)gpost + lane; const f32x4* gn = (const f32x4*)gnext + lane;
    for (int m0 = gw; m0 < M; m0 += 2 * NGW) {
        f32x4 fv[2][4], bv[2][4]; float s[2];
#pragma unroll
        for (int q = 0; q < 2; ++q) { const int m = m0 + q * NGW; if (m < M) {
            const v2u* fr = (const v2u*)(f + (size_t)m * D) + lane;
#pragma unroll
            for (int j = 0; j < 4; ++j) { const v2u w = fr[64 * j]; fv[q][j] = (f32x4){bf_lo(w.x), bf_hi(w.x), bf_lo(w.y), bf_hi(w.y)}; }
            if (BASE_BF16) { const v2u* br = (const v2u*)((const bf16*)base + (size_t)m * D) + lane;
#pragma unroll
                for (int j = 0; j < 4; ++j) { const v2u w = br[64 * j]; bv[q][j] = (f32x4){bf_lo(w.x), bf_hi(w.x), bf_lo(w.y), bf_hi(w.y)}; } }
            else { const f32x4* br = (const f32x4*)((const float*)base + (size_t)m * D) + lane;
#pragma unroll
                for (int j = 0; j < 4; ++j) bv[q][j] = br[64 * j]; } } }
#pragma unroll
        for (int q = 0; q < 2; ++q) { s[q] = 0.f;
#pragma unroll
            for (int j = 0; j < 4; ++j) s[q] += (fv[q][j].x * fv[q][j].x + fv[q][j].y * fv[q][j].y) + (fv[q][j].z * fv[q][j].z + fv[q][j].w * fv[q][j].w); }
#pragma unroll
        for (int o = 1; o < 64; o <<= 1) { s[0] += __shfl_xor(s[0], o); s[1] += __shfl_xor(s[1], o); }
        float s2[2];
#pragma unroll
        for (int q = 0; q < 2; ++q) { const int m = m0 + q * NGW; const float rs = scale / sqrtf(s[q] * (1.f / D) + EPS); s2[q] = 0.f;
#pragma unroll
            for (int j = 0; j < 4; ++j) { const f32x4 gg = gp[64 * j]; bv[q][j] = bv[q][j] + fv[q][j] * rs * gg; }
            if (m < M) {
                if (OUT_BF16) { v2u* ho = (v2u*)((bf16*)hout + (size_t)m * D) + lane;
#pragma unroll
                    for (int j = 0; j < 4; ++j) { v2u o; o.x = pk2(bv[q][j].x, bv[q][j].y); o.y = pk2(bv[q][j].z, bv[q][j].w); ho[64 * j] = o;
                        bv[q][j] = (f32x4){bf_lo(o.x), bf_hi(o.x), bf_lo(o.y), bf_hi(o.y)}; } }
                else { f32x4* ho = (f32x4*)((float*)hout + (size_t)m * D) + lane;
#pragma unroll
                    for (int j = 0; j < 4; ++j) ho[64 * j] = bv[q][j]; } }
#pragma unroll
            for (int j = 0; j < 4; ++j) s2[q] += (bv[q][j].x * bv[q][j].x + bv[q][j].y * bv[q][j].y) + (bv[q][j].z * bv[q][j].z + bv[q][j].w * bv[q][j].w); }
        if (gnext) {
#pragma unroll
            for (int o = 1; o < 64; o <<= 1) { s2[0] += __shfl_xor(s2[0], o); s2[1] += __shfl_xor(s2[1], o); }
#pragma unroll
            for (int q = 0; q < 2; ++q) { const int m = m0 + q * NGW; if (m < M) { const float rs2 = 1.0f / sqrtf(s2[q] * (1.f / D) + EPS);
                v2u* o8 = (v2u*)(xn + (size_t)m * D) + lane;
#pragma unroll
                for (int j = 0; j < 4; ++j) { const f32x4 gg = gn[64 * j]; v2u o; o.x = pk2(bv[q][j].x * rs2 * gg.x, bv[q][j].y * rs2 * gg.y); o.y = pk2(bv[q][j].z * rs2 * gg.z, bv[q][j].w * rs2 * gg.w); o8[64 * j] = o; } } }
        }
    }
}

__device__ __forceinline__ int crow(int r, int hi) { return (r & 3) + 8 * (r >> 2) + 4 * hi; }
#define MFMA32(a, b, c) __builtin_amdgcn_mfma_f32_32x32x16_bf16((a), (b), (c), 0, 0, 0)
__device__ __forceinline__ void attn_phase(LAS unsigned char* lds, const bf16* Q, const bf16* Kb, const bf16* Vt, bf16* O, const float* rel_table, int G, int bid) {
    const int tid = threadIdx.x, lane = tid & 63, r = lane & 31, hi = lane >> 5; const int w = __builtin_amdgcn_readfirstlane(tid >> 6);
    constexpr int PITCH = 144, TILE = 64 * PITCH;
    LAS unsigned char* Ks = lds; LAS unsigned char* Vs = lds + 2 * TILE; LAS float* tbl = (LAS float*)(lds + 4 * TILE);
    const int srow = tid >> 3, sc = tid & 7, soff = srow * PITCH + sc * 16;
    for (int u = bid; u < BATCH * NH * 32; u += G) {
        const int cg4 = u & 31, h = (u >> 5) & 7, b = u >> 8;
        const int c0 = cg4 * 4, c = c0 + (w >> 1);
        const int kt_first = c0 - 8 > 0 ? c0 - 8 : 0, kt_last = c0 + 3;
        const size_t tokb = (size_t)b * SEQ;
        if (tid < 257) tbl[tid] = (rel_table[h * 257 + tid] - rel_table[h * 257 + 256]) * LOG2E;
        const int qpos = c * 64 + 32 * (w & 1) + r;
        bf16x8 qf[4];
        { const bf16* qp = Q + (tokb + qpos) * DA + h * HD + 8 * hi;
#pragma unroll
          for (int d0 = 0; d0 < 4; ++d0) qf[d0] = *(const bf16x8*)(qp + 16 * d0); }
        f32x16 o0, o1;
#pragma unroll
        for (int i = 0; i < 16; ++i) { o0[i] = 0.f; o1[i] = 0.f; }
        float mrow = 0.f, lsum = 0.f; f32x16 negm;
#pragma unroll
        for (int i = 0; i < 16; ++i) negm[i] = 0.f;
        const bf16* kg = Kb + (tokb + srow) * DA + h * HD + sc * 8;
        const bf16* vg = Vt + (size_t)(h * HD + srow) * M + tokb + sc * 8;
        v4u kregA = *(const v4u*)(kg + (size_t)kt_first * 64 * DA), vregA = *(const v4u*)(vg + kt_first * 64);
        v4u kregB = *(const v4u*)(kg + (size_t)(kt_first + 1) * 64 * DA), vregB = *(const v4u*)(vg + (kt_first + 1) * 64);
        *(LAS v4u*)(Ks + soff) = kregA; *(LAS v4u*)(Vs + soff) = vregA;
        __syncthreads();
        int cur = 0;
        for (int kt2 = kt_first; kt2 <= kt_last; kt2 += 2) {
#pragma unroll
          for (int hf = 0; hf < 2; ++hf) {
            const int kt = kt2 + hf;
            if (kt + 2 <= kt_last) {
                if (hf == 0) { kregA = *(const v4u*)(kg + (size_t)(kt + 2) * 64 * DA); vregA = *(const v4u*)(vg + (kt + 2) * 64); }
                else { kregB = *(const v4u*)(kg + (size_t)(kt + 2) * 64 * DA); vregB = *(const v4u*)(vg + (kt + 2) * 64); } }
            if (kt >= c - 8 && kt <= c) {
                const LAS unsigned char* kb = Ks + cur * TILE + r * PITCH + hi * 16;
                const bool nearT = kt >= c - 2;
                const bool first = kt == (c - 8 > 0 ? c - 8 : 0);
                f32x16 p0, p1;
#pragma unroll
                for (int d0 = 0; d0 < 4; ++d0) {
                    const bf16x8 k0 = *(const LAS bf16x8*)(kb + d0 * 32), k1 = *(const LAS bf16x8*)(kb + 32 * PITCH + d0 * 32);
                    if (d0 == 0) { p0 = MFMA32(k0, qf[0], negm); p1 = MFMA32(k1, qf[0], negm); }
                    else { p0 = MFMA32(k0, qf[d0], p0); p1 = MFMA32(k1, qf[d0], p1); } }
                if (nearT) {
                    const int dbase = qpos - kt * 64 - 4 * hi;
#pragma unroll
                    for (int i = 0; i < 16; ++i) { int d_ = dbase - ((i & 3) + 8 * (i >> 2));
                        int i0 = d_ < -128 ? -128 : (d_ > 128 ? 128 : d_); int d1 = d_ - 32; int i1 = d1 < -128 ? -128 : (d1 > 128 ? 128 : d1);
                        p0[i] += tbl[i0 + 128]; p1[i] += tbl[i1 + 128]; }
                }
                float mx = fmaxf(fmaxf(p0[0], p0[1]), p1[0]);
#pragma unroll
                for (int i = 2; i < 16; i += 2) mx = fmaxf(fmaxf(mx, p0[i]), p0[i + 1]);
#pragma unroll
                for (int i = 1; i < 15; i += 2) mx = fmaxf(fmaxf(mx, p1[i]), p1[i + 1]);
                mx = fmaxf(mx, p1[15]);
                mx = fmaxf(mx, __shfl_xor(mx, 32));
                if (first || __any(mx > 8.0f)) {
                    const float delta = first ? mx : fmaxf(mx, 0.f);
#pragma unroll
                    for (int i = 0; i < 16; ++i) { p0[i] -= delta; p1[i] -= delta; }
                    mrow += delta;
#pragma unroll
                    for (int i = 0; i < 16; ++i) negm[i] = -mrow;
                    if (!first) { const float fsc = __builtin_amdgcn_exp2f(-delta); lsum *= fsc;
#pragma unroll
                        for (int i = 0; i < 16; ++i) { o0[i] *= fsc; o1[i] *= fsc; } }
                }
                float ps = 0.f;
#pragma unroll
                for (int i = 0; i < 16; ++i) { p0[i] = __builtin_amdgcn_exp2f(p0[i]); p1[i] = __builtin_amdgcn_exp2f(p1[i]); ps += p0[i] + p1[i]; }
                lsum += ps;
                bf16x8 pf[4];
                { v4u t;
                  t.x = pk2(p0[0], p0[1]); t.y = pk2(p0[2], p0[3]); t.z = pk2(p0[4], p0[5]); t.w = pk2(p0[6], p0[7]); pf[0] = __builtin_bit_cast(bf16x8, t);
                  t.x = pk2(p0[8], p0[9]); t.y = pk2(p0[10], p0[11]); t.z = pk2(p0[12], p0[13]); t.w = pk2(p0[14], p0[15]); pf[1] = __builtin_bit_cast(bf16x8, t);
                  t.x = pk2(p1[0], p1[1]); t.y = pk2(p1[2], p1[3]); t.z = pk2(p1[4], p1[5]); t.w = pk2(p1[6], p1[7]); pf[2] = __builtin_bit_cast(bf16x8, t);
                  t.x = pk2(p1[8], p1[9]); t.y = pk2(p1[10], p1[11]); t.z = pk2(p1[12], p1[13]); t.w = pk2(p1[14], p1[15]); pf[3] = __builtin_bit_cast(bf16x8, t); }
                const LAS unsigned char* vb = Vs + cur * TILE + r * PITCH + hi * 8;
#pragma unroll
                for (int s = 0; s < 4; ++s) {
                    const int kvb = ((s >> 1) * 32 + (s & 1) * 16) * 2;
                    const s16x4 a0 = *(const LAS s16x4*)(vb + kvb), a1 = *(const LAS s16x4*)(vb + kvb + 16);
                    const s16x4 b0 = *(const LAS s16x4*)(vb + 32 * PITCH + kvb), b1 = *(const LAS s16x4*)(vb + 32 * PITCH + kvb + 16);
                    const bf16x8 va = __builtin_shufflevector(a0, a1, 0, 1, 2, 3, 4, 5, 6, 7), vbb = __builtin_shufflevector(b0, b1, 0, 1, 2, 3, 4, 5, 6, 7);
                    o0 = MFMA32(va, pf[s], o0); o1 = MFMA32(vbb, pf[s], o1); }
            }
            if (kt + 1 <= kt_last) {
                if (hf == 0) { *(LAS v4u*)(Ks + (cur ^ 1) * TILE + soff) = kregB; *(LAS v4u*)(Vs + (cur ^ 1) * TILE + soff) = vregB; }
                else { *(LAS v4u*)(Ks + (cur ^ 1) * TILE + soff) = kregA; *(LAS v4u*)(Vs + (cur ^ 1) * TILE + soff) = vregA; } }
            __syncthreads();
            cur ^= 1;
          }
        }
        lsum += __shfl_xor(lsum, 32);
        const float inv = 1.0f / lsum;
        bf16* op = O + (tokb + qpos) * D + h * HD + 4 * hi;
#pragma unroll
        for (int g = 0; g < 4; ++g) {
            v2u a; a.x = pk2(o0[4 * g] * inv, o0[4 * g + 1] * inv); a.y = pk2(o0[4 * g + 2] * inv, o0[4 * g + 3] * inv); *(v2u*)(op + 8 * g) = a;
            v2u bb; bb.x = pk2(o1[4 * g] * inv, o1[4 * g + 1] * inv); bb.y = pk2(o1[4 * g + 2] * inv, o1[4 * g + 3] * inv); *(v2u*)(op + 32 + 8 * g) = bb; }
    }
}

__device__ __forceinline__ void conv_phase(LAS unsigned char* lds, const bf16* Cin, const float* dw_w, const float* dw_b, const float* ln_g, const float* ln_b, bf16* CB, int G, int bid) {
    const int tid = threadIdx.x, lane = tid & 63; const int w = __builtin_amdgcn_readfirstlane(tid >> 6);
    LAS unsigned char* tin = lds; LAS float* tout = (LAS float*)(lds + 62 * 1024);
    const int cp = tid & 255, rh = tid >> 8;
    for (int u = bid; u < M / 32; u += G) {
        const int t0 = u * 32, s0 = t0 & (SEQ - 1);
        { v4u tv[8];
#pragma unroll
          for (int i = 0; i < 8; ++i) { const int p = tid + 512 * i, row = p >> 6, c16 = p & 63; tv[i] = (v4u){0u, 0u, 0u, 0u};
              if (p < 62 * 64 && s0 - 30 + row >= 0) tv[i] = *(const v4u*)(Cin + (size_t)(t0 - 30 + row) * DC + c16 * 8); }
#pragma unroll
          for (int i = 0; i < 8; ++i) { const int p = tid + 512 * i, row = p >> 6, c16 = p & 63;
              if (p < 62 * 64) *(LAS v4u*)(tin + row * 1024 + c16 * 16) = tv[i]; } }
        __syncthreads();
        { f32x2 in[46];
#pragma unroll
          for (int i = 0; i < 46; ++i) { const unsigned v = *(const LAS unsigned*)(tin + (16 * rh + i) * 1024 + cp * 4); in[i] = (f32x2){bf_lo(v), bf_hi(v)}; }
          f32x2 acc[16];
          { const f32x2 bb = *(const f32x2*)(dw_b + 2 * cp);
#pragma unroll
            for (int t = 0; t < 16; ++t) acc[t] = bb; }
#pragma unroll
          for (int j = 0; j < 31; ++j) { const f32x2 ww = *(const f32x2*)(dw_w + j * DC + 2 * cp);
#pragma unroll
              for (int t = 0; t < 16; ++t) acc[t] += ww * in[t + j]; }
#pragma unroll
          for (int t = 0; t < 16; ++t) *(LAS f32x2*)(tout + (16 * rh + t) * DC + 2 * cp) = acc[t]; }
        __syncthreads();
        const f32x4 g0 = *(const f32x4*)(ln_g + lane * 8), g1 = *(const f32x4*)(ln_g + lane * 8 + 4), b0 = *(const f32x4*)(ln_b + lane * 8), b1 = *(const f32x4*)(ln_b + lane * 8 + 4);
#pragma unroll
        for (int rr = 0; rr < 4; ++rr) { const int row = 4 * w + rr;
            f32x4 v0 = *(const LAS f32x4*)(tout + row * DC + lane * 8), v1 = *(const LAS f32x4*)(tout + row * DC + lane * 8 + 4);
            const float mean = wave_sum((v0.x + v0.y) + (v0.z + v0.w) + (v1.x + v1.y) + (v1.z + v1.w)) * (1.f / DC);
            v0 = v0 - mean; v1 = v1 - mean;
            const float var = wave_sum((v0.x * v0.x + v0.y * v0.y) + (v0.z * v0.z + v0.w * v0.w) + (v1.x * v1.x + v1.y * v1.y) + (v1.z * v1.z + v1.w * v1.w)) * (1.f / DC);
            const float rstd = 1.0f / sqrtf(var + EPS);
            v0 = v0 * rstd * g0 + b0; v1 = v1 * rstd * g1 + b1;
            v0 = v0 * pg8::sigm4(v0); v1 = v1 * pg8::sigm4(v1);
            v4u o; o.x = pk2(v0.x, v0.y); o.y = pk2(v0.z, v0.w); o.z = pk2(v1.x, v1.y); o.w = pk2(v1.z, v1.w);
            *(v4u*)(CB + (size_t)(t0 + row) * D + DC + lane * 8) = o; }
        __syncthreads();
    }
}

struct Args { const float* in[24]; float* out; unsigned char* ws; int ph_lo, ph_hi; };
__global__ void __launch_bounds__(NWAVES * 64, 2) mega_fwd(Args a) {
    extern __shared__ __attribute__((aligned(16))) unsigned char lds_raw[];
    cg::grid_group grid = cg::this_grid();
    LAS unsigned char* lds = (LAS unsigned char*)lds_raw;
    const int tid = threadIdx.x, lane = tid & 63, wave = __builtin_amdgcn_readfirstlane(tid >> 6);
    const int G = gridDim.x, bid = blockIdx.x;
    unsigned char* ws = a.ws;
    bf16* XN = (bf16*)(ws + WS_XN); bf16* F = (bf16*)(ws + WS_F); bf16* H = (bf16*)(ws + WS_H); bf16* HB = (bf16*)(ws + WS_BIG);
    bf16* Qb = (bf16*)(ws + WS_Q); bf16* Kb = (bf16*)(ws + WS_K); bf16* Vt = (bf16*)(ws + WS_VT); bf16* Cb = (bf16*)(ws + WS_C); bf16* Ob = (bf16*)(ws + WS_O); bf16* CBb = Ob;
    bf16* MERGED = XN;
    bf16* GT = (bf16*)a.out;
    const float* x = a.in[0];
    volatile LAS unsigned* MISC = (volatile LAS unsigned*)(lds + RING_BYTES);
    if (tid < 16) MISC[tid] = 0u;
    if (bid == 0) {
        for (int i = tid; i < 4096; i += NWAVES * 64) ((unsigned*)ws)[i] = 0u;
        asm volatile("s_waitcnt vmcnt(0)" ::: "memory"); __builtin_amdgcn_fence(__ATOMIC_RELEASE, "agent"); asm volatile("s_waitcnt vmcnt(0)" ::: "memory");
    }
    __syncthreads();
    grid.sync();
    XcdBarrier bar = xcd_barrier_post((unsigned*)ws, MISC + 8);
#define GRID_SYNC() xcd_barrier(bar)

    if (a.ph_lo <= 0 && 0 < a.ph_hi) {
    { WPtrs P{a.in[2], a.in[3], a.in[4], a.in[20], a.in[21], a.in[22], a.in[7], a.in[10], a.in[16], a.in[17]};
      p0_prologue(lds, P, ws, x, a.in[1], G, bid, wave, lane); }
    if (a.ph_lo <= 0 && 1 < a.ph_hi) GRID_SYNC();
    }
    if (a.ph_lo <= 1 && 1 < a.ph_hi) {
    { pg8::Gemm g{XN, (const bf16*)(ws + WS_WGU1), M, NGU, D, D}; pg8::StaticOrder S; S.init(M, NGU, G, bid);
      pg8::EpiSwiGLU E{HB, FF}; pg8::gemm_phase<pg8::EpiSwiGLU, pg8::StaticOrder, true, true>(lds, g, S, E); }
    if (a.ph_lo <= 1 && 2 < a.ph_hi) GRID_SYNC();
    }
    if (a.ph_lo <= 2 && 2 < a.ph_hi) {
    { pg8::Gemm g{HB, (const bf16*)(ws + WS_WD1), M, D, FF, FF}; pg8::StaticOrder S; S.init(M, D, G, bid);
      pg8::EpiStore E{F, D}; pg8::gemm_phase<pg8::EpiStore, pg8::StaticOrder, true, true>(lds, g, S, E); }
    if (a.ph_lo <= 2 && 3 < a.ph_hi) GRID_SYNC();
    }
    if (a.ph_lo <= 3 && 3 < a.ph_hi) {
    row_pass<false, true>(x, F, a.in[5], 0.5f, H, a.in[6], XN, G, bid, wave, lane);
    if (a.ph_lo <= 3 && 4 < a.ph_hi) GRID_SYNC();
    }
    if (a.ph_lo <= 4 && 4 < a.ph_hi) {
    { pg8::Gemm g{XN, (const bf16*)(ws + WS_WMIX), M, NMIX, D, D}; pg8::StaticOrder S; S.init(M, NMIX, G, bid);
      pg8::EpiMix E{Qb, Kb, Cb, GT, a.in[11], a.in[8], QSCALE}; pg8::gemm_phase<pg8::EpiMix, pg8::StaticOrder, true, true>(lds, g, S, E); }
    { pg8::Gemm g{(const bf16*)(ws + WS_WV), XN, DA, M, D, D}; pg8::StaticOrder S; S.init(DA, M, G, bid);
      pg8::EpiStore E{Vt, M}; pg8::gemm_phase<pg8::EpiStore, pg8::StaticOrder, true, true>(lds, g, S, E); }
    if (a.ph_lo <= 4 && 5 < a.ph_hi) GRID_SYNC();
    }
    if (a.ph_lo <= 5 && 5 < a.ph_hi) {
    attn_phase(lds, Qb, Kb, Vt, Ob, a.in[9], G, bid);
    conv_phase(lds, Cb, a.in[12], a.in[13], a.in[14], a.in[15], CBb, G, bid);
    if (a.ph_lo <= 5 && 6 < a.ph_hi) GRID_SYNC();
    }
    if (a.ph_lo <= 6 && 6 < a.ph_hi) {
    { pg8::Gemm g{Ob, (const bf16*)(ws + WS_WAO), M, D, DA, D}; pg8::HalfOrder S; S.init(M, D, G, bid);
      pg8::EpiGateMid E{MERGED, GT}; pg8::gemm_phase<pg8::EpiGateMid, pg8::HalfOrder, true, true>(lds, g, S, E); }
    if (a.ph_lo <= 6 && 7 < a.ph_hi) GRID_SYNC();
    }
    if (a.ph_lo <= 7 && 7 < a.ph_hi) {
    { pg8::Gemm g{MERGED, (const bf16*)(ws + WS_WOUT), M, D, D, D}; pg8::StaticOrder S; S.init(M, D, G, bid);
      pg8::EpiStore E{F, D}; pg8::gemm_phase<pg8::EpiStore, pg8::StaticOrder, true, true>(lds, g, S, E); }
    if (a.ph_lo <= 7 && 8 < a.ph_hi) GRID_SYNC();
    }
    if (a.ph_lo <= 8 && 8 < a.ph_hi) {
    row_pass<true, true>(H, F, a.in[18], 1.0f, H, a.in[19], XN, G, bid, wave, lane);
    if (a.ph_lo <= 8 && 9 < a.ph_hi) GRID_SYNC();
    }
    if (a.ph_lo <= 9 && 9 < a.ph_hi) {
    { pg8::Gemm g{XN, (const bf16*)(ws + WS_WGU2), M, NGU, D, D}; pg8::StaticOrder S; S.init(M, NGU, G, bid);
      pg8::EpiSwiGLU E{HB, FF}; pg8::gemm_phase<pg8::EpiSwiGLU, pg8::StaticOrder, true, true>(lds, g, S, E); }
    if (a.ph_lo <= 9 && 10 < a.ph_hi) GRID_SYNC();
    }
    if (a.ph_lo <= 10 && 10 < a.ph_hi) {
    { pg8::Gemm g{HB, (const bf16*)(ws + WS_WD2), M, D, FF, FF}; pg8::StaticOrder S; S.init(M, D, G, bid);
      pg8::EpiStore E{F, D}; pg8::gemm_phase<pg8::EpiStore, pg8::StaticOrder, true, true>(lds, g, S, E); }
    if (a.ph_lo <= 10 && 11 < a.ph_hi) GRID_SYNC();
    }
    if (a.ph_lo <= 11 && 11 < a.ph_hi) {
    row_pass<true, false>(H, F, a.in[23], 0.5f, a.out, nullptr, nullptr, G, bid, wave, lane);
    }
#ifdef DBG_END
    if (a.ph_lo == 99) {
        const int gw = bid * NWAVES + wave, NGW = G * NWAVES;
        if (DBG_END == 55) { for (int m = gw; m < M; m += NGW) { float* o = a.out + (size_t)m * D; float v[16];
#pragma unroll
            for (int j = 0; j < 16; ++j) v[j] = bf_lo(GT[(size_t)m * 2048 + lane + 64 * j]) + bf_lo(GT[(size_t)m * 2048 + 1024 + lane + 64 * j]);
            asm volatile("s_waitcnt vmcnt(0)" ::: "memory");
#pragma unroll
            for (int j = 0; j < 16; ++j) o[lane + 64 * j] = v[j]; } }
        else for (int m = gw; m < M; m += NGW) { float* o = a.out + (size_t)m * D;
            for (int j = lane; j < D; j += 64) {
                float v;
                if (DBG_END <= 4) v = bf_lo(H[(size_t)m * D + j]);
                else if (DBG_END == 5) v = j < 512 ? bf_lo(Qb[(size_t)m * 512 + j]) + bf_lo(Kb[(size_t)m * 512 + j]) : bf_lo(Cb[(size_t)m * 512 + j - 512]) + bf_lo(Vt[(size_t)(j - 512) * M + m]);
                else if (DBG_END == 6) v = bf_lo(Ob[(size_t)m * D + j]);
                else if (DBG_END == 7) v = bf_lo(MERGED[(size_t)m * D + j]);
                else v = bf_lo(F[(size_t)m * D + j]);
                o[j] = v; } }
    }
#endif
}

extern "C" void kernel_launch(void* const* d_in, const int* in_sizes, int n_in, void* d_out, int out_size, void* d_ws, size_t ws_size, hipStream_t stream) {
    static int grid = 0;
    if (grid == 0) {
        if (n_in != 24 || in_sizes[0] != M * D || out_size != M * D || ws_size < WS_END) { fprintf(stderr, "kernel_launch: unexpected shapes (n_in %d, in0 %d, out %d, ws %zu); nothing launched\n", n_in, n_in > 0 ? in_sizes[0] : -1, out_size, ws_size); grid = -1; return; }
        int dev = 0, cus = 0, per_cu = 0;
        if (hipGetDevice(&dev) != hipSuccess || hipDeviceGetAttribute(&cus, hipDeviceAttributeMultiprocessorCount, dev) != hipSuccess) { grid = -1; return; }
        if (hipFuncSetAttribute((const void*)mega_fwd, hipFuncAttributeMaxDynamicSharedMemorySize, LDS_BYTES) != hipSuccess) { fprintf(stderr, "kernel_launch: hipFuncSetAttribute failed\n"); grid = -1; return; }
        if (hipOccupancyMaxActiveBlocksPerMultiprocessor(&per_cu, (const void*)mega_fwd, NWAVES * 64, LDS_BYTES) != hipSuccess || per_cu < 1) { fprintf(stderr, "kernel_launch: occupancy query reports %d blocks per CU\n", per_cu); (void)hipGetLastError(); grid = -1; return; }
        grid = cus;
    }
    if (grid < 0) return;
    Args a{};
    for (int i = 0; i < 24; ++i) a.in[i] = (const float*)d_in[i];
    a.out = (float*)d_out; a.ws = (unsigned char*)d_ws;
    void* args[] = {&a};
#if MK_N_LAUNCHES == 1
    a.ph_lo = 0; a.ph_hi = 12;
    hipError_t e = hipLaunchCooperativeKernel((const void*)mega_fwd, dim3(grid), dim3(NWAVES * 64), args, LDS_BYTES, stream);
    if (e != hipSuccess) fprintf(stderr, "kernel_launch: cooperative launch failed: %s (grid %d)\n", hipGetErrorString(e), grid);
#else
#ifdef DBG_END
    for (int p = 0; p < (DBG_END == 55 ? 5 : DBG_END); ++p) { a.ph_lo = p; a.ph_hi = p + 1; hipLaunchKernelGGL(mega_fwd, dim3(grid), dim3(NWAVES * 64), LDS_BYTES, stream, a); }
    a.ph_lo = 99; a.ph_hi = 100; hipLaunchKernelGGL(mega_fwd, dim3(grid), dim3(NWAVES * 64), LDS_BYTES, stream, a);
#else
    for (int p = 0; p < 12; ++p) { a.ph_lo = p; a.ph_hi = p + 1; hipLaunchKernelGGL(mega_fwd, dim3(grid), dim3(NWAVES * 64), LDS_BYTES, stream, a); }
#endif
#endif
}
```

```cpp
#include <hip/hip_runtime.h>
#include <hip/hip_cooperative_groups.h>
#include <cstdio>
#include <cstdint>
namespace cg = cooperative_groups;
namespace pg8 {
#define PG8_LAS __attribute__((address_space(3)))
typedef unsigned short bf16_t;
typedef short bf16x8 __attribute__((ext_vector_type(8)));
typedef float f32x4 __attribute__((ext_vector_type(4)));
typedef unsigned u32x4 __attribute__((ext_vector_type(4)));
constexpr int BM = 256, BK = 64, HALF = 128, HTB = HALF * BK * 2  , STAGE_BYTES = 8 * HTB, NXCD = 8, WGM = 4;

__host__ __device__ __forceinline__ int lds_byte(int r, int c) { const int st = (r >> 4) * 2 + (c >> 5), rr = r & 15, cc = c & 31, ob = rr * 64 + cc * 2; return st * 1024 + (ob ^ (((ob >> 9) & 1) << 5)); }
__host__ __device__ __forceinline__ void stage_rc(int b, int& R, int& C) { const int st = b / 1024, sb = b % 1024, swz = sb ^ (((sb >> 9) & 1) << 5); R = (st >> 1) * 16 + swz / 64; C = (st & 1) * 32 + (swz % 64) / 2; }
__host__ __device__ __forceinline__ int perm32(int rho) { const int n = rho >> 4, i = rho & 15; return 8 * (i >> 2) + 4 * n + (i & 3); }

struct Unit { int pm, pn, kh; };
struct Gemm { const bf16_t* A; const bf16_t* Bt; int M, N, K, ld; };

struct StaticOrder {
    int nM, nN, nwg, G, c;
    __host__ __device__ void init(int M, int N, int G_, int c_) { nM = M / BM; nN = N / BM; nwg = nM * nN; G = G_; c = c_; }
    __host__ __device__ bool next(int i, Unit& u) const {
        const long L = (long)i * G + c; if (L >= nwg) return false;
        int wgid = (int)L; { const int q = nwg / NXCD, r = nwg % NXCD, xcd = wgid % NXCD, off = wgid / NXCD; wgid = (xcd < r ? xcd * (q + 1) : r * (q + 1) + (xcd - r) * q) + off; }
        const int nig = WGM * nN, gid = wgid / nig, fm = gid * WGM, gsz = (nM - fm) < WGM ? (nM - fm) : WGM;
        u.pm = fm + ((wgid % nig) % gsz); u.pn = (wgid % nig) / gsz; u.kh = 0; return true;
    }
    __device__ __forceinline__ void a_ready(const Unit&) const {}
    __device__ __forceinline__ void done(const Unit&) const {}
};

struct HalfOrder {
    StaticOrder so;
    __host__ __device__ void init(int M, int N, int G_, int c_) { so.init(M, N, G_, c_); }
    __host__ __device__ bool next(int i, Unit& u) const { if (!so.next(i >> 1, u)) return false; u.kh = i & 1; return true; }
    __device__ __forceinline__ void a_ready(const Unit&) const {}
    __device__ __forceinline__ void done(const Unit&) const {}
};
typedef float f32x2 __attribute__((ext_vector_type(2)));
typedef __bf16 bf16x2v __attribute__((ext_vector_type(2)));
__device__ __forceinline__ unsigned cvt_pk_bf16(float lo, float hi) { f32x2 v = {lo, hi}; bf16x2v b = __builtin_convertvector(v, bf16x2v); return __builtin_bit_cast(unsigned, b); }
template <class Epi, class Sched, bool ALIGN_EPI = false, bool SP2 = false>
__device__ __forceinline__ void gemm_phase(PG8_LAS unsigned char* lds, const Gemm g, const Sched& S, const Epi& E) {
    const int tid = threadIdx.x, wid = __builtin_amdgcn_readfirstlane(tid >> 6), lane = tid & 63, wr = wid >> 2, wc = wid & 3, fr = lane & 15, fq = lane >> 4;
    const int K = g.ld, nt = g.K / BK;
    unsigned voffA[2], voffB[2];
#pragma unroll
    for (int i = 0; i < 2; ++i) { int R, C; stage_rc(tid * 16 + i * 8192, R, C); const int Rb = Epi::PERM ? ((R & ~31) + perm32(R & 31)) : R;
        voffA[i] = (unsigned)(R * K + C) * 2u; voffB[i] = (unsigned)(Rb * K + C) * 2u; }
    const size_t kstep = (size_t)(BK * 2);
    const size_t hstep = (size_t)HALF * K * 2;
    const size_t tstep = 2 * hstep;
    const unsigned ldsw = (unsigned)wid * 1024u;
    const int aoff = lds_byte(wr * 64 + fr, fq * 8), boff = lds_byte(wc * 32 + fr, fq * 8);
#define PG8_SA(b, h) (((b) * 2 + (h)) * HTB)
#define PG8_SB(b, h) ((4 + (b) * 2 + (h)) * HTB)
#define PG8_STAGE(bufoff, gbase, voff) do { _Pragma("unroll") for (int _i = 0; _i < 2; ++_i) \
        __builtin_amdgcn_global_load_lds((const unsigned*)((const char*)(gbase) + (voff)[_i]), (PG8_LAS unsigned*)(lds + (bufoff) + ldsw + _i * 8192), 16, 0, 0); } while (0)
#define PG8_LDA(dst, b, h) do { _Pragma("unroll") for (int m = 0; m < 4; ++m) _Pragma("unroll") for (int k = 0; k < 2; ++k) dst[m][k] = *(const PG8_LAS bf16x8*)(lds + PG8_SA(b, h) + aoff + m * 2048 + k * 1024); } while (0)
#define PG8_LDB(dst, b, h) do { _Pragma("unroll") for (int n = 0; n < 2; ++n) _Pragma("unroll") for (int k = 0; k < 2; ++k) dst[n][k] = *(const PG8_LAS bf16x8*)(lds + PG8_SB(b, h) + boff + n * 2048 + k * 1024); } while (0)
#define PG8_MMA(ai, bj, At, Bt) do { __builtin_amdgcn_s_setprio(1); _Pragma("unroll") for (int m = 0; m < 4; ++m) _Pragma("unroll") for (int n = 0; n < 2; ++n) _Pragma("unroll") for (int k = 0; k < 2; ++k) \
        acc[ai][bj][m][n] = __builtin_amdgcn_mfma_f32_16x16x32_bf16(Bt[n][k], At[m][k], acc[ai][bj][m][n], 0, 0, 0); __builtin_amdgcn_s_setprio(0); } while (0)
#define PG8_WAIT_V(n) asm volatile("s_waitcnt vmcnt(" #n ")" ::: "memory")
#define PG8_WAIT_L(n) asm volatile("s_waitcnt lgkmcnt(" #n ")" ::: "memory")
#define PG8_BAR __builtin_amdgcn_s_barrier()
#define PG8_SCHED __builtin_amdgcn_sched_barrier(0)
    Unit cur, nxt; int ui = 0;
    if (!S.next(0, cur)) return;
    f32x4 acc[2][2][4][2];
#pragma unroll
    for (int a = 0; a < 2; ++a)
#pragma unroll
        for (int b = 0; b < 2; ++b)
#pragma unroll
            for (int m = 0; m < 4; ++m)
#pragma unroll
                for (int n = 0; n < 2; ++n) acc[a][b][m][n] = (f32x4){0.f, 0.f, 0.f, 0.f};
    bf16x8 At[4][2], B0[2][2], B1[2][2];
    const size_t khstep = (size_t)g.K * 2;
    const char* cA = (const char*)g.A + (size_t)cur.pm * tstep + cur.kh * khstep; const char* cB = (const char*)g.Bt + (size_t)cur.pn * tstep + cur.kh * khstep;
    S.a_ready(cur);
    if constexpr (SP2) {
        PG8_STAGE(PG8_SB(0, 0), cB, voffB); PG8_STAGE(PG8_SB(0, 1), cB + hstep, voffB); PG8_STAGE(PG8_SA(0, 0), cA, voffA); PG8_STAGE(PG8_SA(0, 1), cA + hstep, voffA);
        if (wr == 1) PG8_BAR;
        PG8_WAIT_V(2); PG8_BAR;
        PG8_STAGE(PG8_SB(1, 0), cB + kstep, voffB); PG8_STAGE(PG8_SA(1, 0), cA + kstep, voffA); PG8_STAGE(PG8_SB(1, 1), cB + hstep + kstep, voffB);
        PG8_WAIT_V(6); PG8_BAR;
    } else {
        PG8_STAGE(PG8_SB(0, 0), cB, voffB); PG8_STAGE(PG8_SA(0, 0), cA, voffA); PG8_STAGE(PG8_SB(0, 1), cB + hstep, voffB); PG8_STAGE(PG8_SA(0, 1), cA + hstep, voffA);
        if (wr == 1) PG8_BAR;
        PG8_WAIT_V(4); PG8_BAR;
        PG8_STAGE(PG8_SB(1, 0), cB + kstep, voffB); PG8_STAGE(PG8_SA(1, 0), cA + kstep, voffA); PG8_STAGE(PG8_SB(1, 1), cB + hstep + kstep, voffB);
        PG8_WAIT_V(6); PG8_BAR;
    }
    for (;;) {
        const bool has_next = S.next(ui + 1, nxt);
        const char* nA = has_next ? (const char*)g.A + (size_t)nxt.pm * tstep + nxt.kh * khstep : cA; const char* nB = has_next ? (const char*)g.Bt + (size_t)nxt.pn * tstep + nxt.kh * khstep : cB;
        for (int t = 0; t < nt; t += 2) {
            const bool last = (t == nt - 2);
            const char* a1 = cA + (size_t)(t + 1) * kstep;
            const char* a2 = last ? nA : cA + (size_t)(t + 2) * kstep; const char* b2 = last ? nB : cB + (size_t)(t + 2) * kstep;
            const char* a3 = a2 + kstep; const char* b3 = b2 + kstep;
            if (last && has_next) S.a_ready(nxt);
            if constexpr (SP2) {
            PG8_LDB(B0, 0, 0); PG8_LDB(B1, 0, 1); PG8_SCHED; PG8_LDA(At, 0, 0); PG8_STAGE(PG8_SA(1, 1), a1 + hstep, voffA);
            PG8_WAIT_V(8); PG8_WAIT_L(0); PG8_BAR; PG8_MMA(0, 0, At, B0); PG8_MMA(0, 1, At, B1); PG8_BAR; PG8_SCHED;
            PG8_LDA(At, 0, 1); PG8_STAGE(PG8_SB(0, 0), b2, voffB); PG8_STAGE(PG8_SB(0, 1), b2 + hstep, voffB); PG8_STAGE(PG8_SA(0, 0), a2, voffA);
            PG8_WAIT_V(8); PG8_WAIT_L(0); PG8_BAR; PG8_MMA(1, 0, At, B0); PG8_MMA(1, 1, At, B1); PG8_BAR; PG8_SCHED;
            PG8_LDB(B0, 1, 0); PG8_LDB(B1, 1, 1); PG8_SCHED; PG8_LDA(At, 1, 0); PG8_STAGE(PG8_SA(0, 1), a2 + hstep, voffA);
            PG8_WAIT_V(8); PG8_WAIT_L(0); PG8_BAR; PG8_MMA(0, 0, At, B0); PG8_MMA(0, 1, At, B1); PG8_BAR; PG8_SCHED;
            PG8_LDA(At, 1, 1); PG8_STAGE(PG8_SB(1, 0), b3, voffB); PG8_STAGE(PG8_SB(1, 1), b3 + hstep, voffB); PG8_STAGE(PG8_SA(1, 0), a3, voffA);
            PG8_WAIT_V(8); PG8_WAIT_L(0); PG8_BAR; PG8_MMA(1, 0, At, B0); PG8_MMA(1, 1, At, B1); PG8_BAR; PG8_SCHED;
            } else {
            PG8_LDB(B0, 0, 0); PG8_SCHED; PG8_LDA(At, 0, 0); PG8_STAGE(PG8_SA(1, 1), a1 + hstep, voffA);
            PG8_WAIT_L(8); PG8_BAR; PG8_WAIT_L(0); PG8_MMA(0, 0, At, B0); PG8_BAR; PG8_SCHED;
            PG8_LDB(B1, 0, 1); PG8_STAGE(PG8_SB(0, 0), b2, voffB);
            PG8_BAR; PG8_WAIT_L(0); PG8_MMA(0, 1, At, B1); PG8_BAR;
            PG8_LDA(At, 0, 1); PG8_STAGE(PG8_SA(0, 0), a2, voffA);
            PG8_BAR; PG8_WAIT_L(0); PG8_MMA(1, 0, At, B0); PG8_BAR; PG8_SCHED;
            PG8_STAGE(PG8_SB(0, 1), b2 + hstep, voffB);
            PG8_WAIT_V(6); PG8_BAR; PG8_MMA(1, 1, At, B1); PG8_BAR;
            PG8_LDB(B0, 1, 0); PG8_SCHED; PG8_LDA(At, 1, 0); PG8_STAGE(PG8_SA(0, 1), a2 + hstep, voffA);
            PG8_WAIT_L(8); PG8_BAR; PG8_WAIT_L(0); PG8_MMA(0, 0, At, B0); PG8_BAR; PG8_SCHED;
            PG8_LDB(B1, 1, 1); PG8_STAGE(PG8_SB(1, 0), b3, voffB);
            PG8_BAR; PG8_WAIT_L(0); PG8_MMA(0, 1, At, B1); PG8_BAR;
            PG8_LDA(At, 1, 1); PG8_STAGE(PG8_SA(1, 0), a3, voffA);
            PG8_BAR; PG8_WAIT_L(0); PG8_MMA(1, 0, At, B0); PG8_BAR; PG8_SCHED;
            PG8_STAGE(PG8_SB(1, 1), b3 + hstep, voffB);
            PG8_WAIT_V(6); PG8_BAR; PG8_MMA(1, 1, At, B1); PG8_BAR;
            }
        }
        if constexpr (ALIGN_EPI) { if (wr == 0) PG8_BAR; }
        bool keep_acc = false;
        if constexpr (Epi::MIDHOOK) { if (cur.kh == 0 && has_next) { E.mid(acc, cur, wr, wc, fr, fq); keep_acc = true; } else { E(acc, cur, wr, wc, fr, fq); } }
        else if constexpr (!Epi::AFTER_DRAIN) { E(acc, cur, wr, wc, fr, fq); S.done(cur); }
        if (!has_next) break;
        if (!keep_acc) {
#pragma unroll
        for (int a = 0; a < 2; ++a)
#pragma unroll
            for (int b = 0; b < 2; ++b)
#pragma unroll
                for (int m = 0; m < 4; ++m)
#pragma unroll
                    for (int n = 0; n < 2; ++n) acc[a][b][m][n] = (f32x4){0.f, 0.f, 0.f, 0.f};
        }
        cur = nxt; cA = nA; cB = nB; ++ui;
        if constexpr (ALIGN_EPI) { if (wr == 1) PG8_BAR; }
    }
    PG8_WAIT_V(0);
    if constexpr (!ALIGN_EPI) { if (wr == 0) PG8_BAR; }
    PG8_BAR;
    if constexpr (Epi::AFTER_DRAIN) { E.fused(acc, cur, wr, wc, fr, fq, lds, wid, lane); S.done(cur); }
#undef PG8_SA
#undef PG8_SB
#undef PG8_STAGE
#undef PG8_LDA
#undef PG8_LDB
#undef PG8_MMA
#undef PG8_WAIT_V
#undef PG8_WAIT_L
#undef PG8_BAR
#undef PG8_SCHED
}
}
namespace pg8 {
__device__ __forceinline__ float sigm(float x) { return __builtin_amdgcn_rcpf(1.0f + __builtin_amdgcn_exp2f(x * -1.4426950408889634f)); }
__device__ __forceinline__ f32x4 sigm4(f32x4 x) { return (f32x4){sigm(x[0]), sigm(x[1]), sigm(x[2]), sigm(x[3])}; }
__device__ __forceinline__ u32x4 pack8(f32x4 a, f32x4 b) { u32x4 w; w.x = cvt_pk_bf16(a[0], a[1]); w.y = cvt_pk_bf16(a[2], a[3]); w.z = cvt_pk_bf16(b[0], b[1]); w.w = cvt_pk_bf16(b[2], b[3]); return w; }
__device__ __forceinline__ void unpack8(u32x4 w, f32x4& a, f32x4& b) {
    a = (f32x4){__uint_as_float(w.x << 16), __uint_as_float(w.x & 0xffff0000u), __uint_as_float(w.y << 16), __uint_as_float(w.y & 0xffff0000u)};
    b = (f32x4){__uint_as_float(w.z << 16), __uint_as_float(w.z & 0xffff0000u), __uint_as_float(w.w << 16), __uint_as_float(w.w & 0xffff0000u)}; }

struct EpiStore {
    static constexpr bool PERM = true, AFTER_DRAIN = false, MIDHOOK = false;
    bf16_t* O; int ldc;
    __device__ __forceinline__ void operator()(const f32x4 (&acc)[2][2][4][2], const Unit& u, int wr, int wc, int fr, int fq) const {
        const int row0 = u.pm * BM + wr * 64 + fr, col0 = u.pn * BM + wc * 32 + 8 * fq;
#pragma unroll
        for (int ai = 0; ai < 2; ++ai)
#pragma unroll
            for (int m = 0; m < 4; ++m) { bf16_t* rowp = O + (size_t)(row0 + ai * HALF + m * 16) * ldc + col0;
#pragma unroll
                for (int bj = 0; bj < 2; ++bj) *(u32x4*)(rowp + bj * HALF) = pack8(acc[ai][bj][m][0], acc[ai][bj][m][1]); }
    }
};
struct EpiSwiGLU {
    static constexpr bool PERM = true, AFTER_DRAIN = false, MIDHOOK = false;
    bf16_t* O; int ldc;
    __device__ __forceinline__ void operator()(const f32x4 (&acc)[2][2][4][2], const Unit& u, int wr, int wc, int fr, int fq) const {
        const int row0 = u.pm * BM + wr * 64 + fr, col0 = u.pn * HALF + wc * 32 + 8 * fq;
#pragma unroll
        for (int ai = 0; ai < 2; ++ai)
#pragma unroll
            for (int m = 0; m < 4; ++m) { bf16_t* rowp = O + (size_t)(row0 + ai * HALF + m * 16) * ldc + col0;
                const f32x4 g0 = acc[ai][0][m][0], g1 = acc[ai][0][m][1], u0 = acc[ai][1][m][0], u1 = acc[ai][1][m][1];
                const f32x4 h0 = g0 * sigm4(g0) * u0, h1 = g1 * sigm4(g1) * u1;
                *(u32x4*)rowp = pack8(h0, h1); }
    }
};
struct EpiMix {
    static constexpr bool PERM = true, AFTER_DRAIN = false, MIDHOOK = false;
    bf16_t* Q; bf16_t* K; bf16_t* C; bf16_t* G; const float* glu_bias; const float* gate_bias; float qscale;
    __device__ __forceinline__ void operator()(const f32x4 (&acc)[2][2][4][2], const Unit& u, int wr, int wc, int fr, int fq) const {
        const int row0 = u.pm * BM + wr * 64 + fr; const int pn = u.pn;
        if (pn < 4) {
            bf16_t* base = pn < 2 ? Q : K; const float sc = pn < 2 ? qscale : 1.0f; const int col0 = (pn & 1) * BM + wc * 32 + 8 * fq;
#pragma unroll
            for (int ai = 0; ai < 2; ++ai)
#pragma unroll
                for (int m = 0; m < 4; ++m) { bf16_t* rowp = base + (size_t)(row0 + ai * HALF + m * 16) * 512 + col0;
#pragma unroll
                    for (int bj = 0; bj < 2; ++bj) *(u32x4*)(rowp + bj * HALF) = pack8(acc[ai][bj][m][0] * sc, acc[ai][bj][m][1] * sc); }
        } else if (pn < 8) {
            const int col0 = (pn - 4) * HALF + wc * 32 + 8 * fq;
            const f32x4 ba0 = *(const f32x4*)(glu_bias + col0), ba1 = *(const f32x4*)(glu_bias + col0 + 4), bg0 = *(const f32x4*)(glu_bias + 512 + col0), bg1 = *(const f32x4*)(glu_bias + 512 + col0 + 4);
#pragma unroll
            for (int ai = 0; ai < 2; ++ai)
#pragma unroll
                for (int m = 0; m < 4; ++m) { bf16_t* rowp = C + (size_t)(row0 + ai * HALF + m * 16) * 512 + col0;
                    const f32x4 a0 = acc[ai][0][m][0] + ba0, a1 = acc[ai][0][m][1] + ba1, g0 = acc[ai][1][m][0] + bg0, g1 = acc[ai][1][m][1] + bg1;
                    *(u32x4*)rowp = pack8(a0 * sigm4(g0), a1 * sigm4(g1)); }
        } else {
            const int col0 = (pn - 8) * BM + wc * 32 + 8 * fq;
#pragma unroll
            for (int bj = 0; bj < 2; ++bj) { const f32x4 b0 = *(const f32x4*)(gate_bias + col0 + bj * HALF), b1 = *(const f32x4*)(gate_bias + col0 + bj * HALF + 4);
#pragma unroll
                for (int ai = 0; ai < 2; ++ai)
#pragma unroll
                    for (int m = 0; m < 4; ++m) { bf16_t* rowp = G + (size_t)(row0 + ai * HALF + m * 16) * 2048 + col0 + bj * HALF;
                        *(u32x4*)rowp = pack8(sigm4(acc[ai][bj][m][0] + b0), sigm4(acc[ai][bj][m][1] + b1)); } }
        }
    }
};
struct EpiGateMid {
    static constexpr bool PERM = true, AFTER_DRAIN = false, MIDHOOK = true;
    bf16_t* O; const bf16_t* G;
    __device__ __forceinline__ void mid(f32x4 (&acc)[2][2][4][2], const Unit& u, int wr, int wc, int fr, int fq) const {
        const int row0 = u.pm * BM + wr * 64 + fr, col0 = u.pn * BM + wc * 32 + 8 * fq;
#pragma unroll
        for (int ai = 0; ai < 2; ++ai)
#pragma unroll
            for (int m = 0; m < 4; ++m) { const bf16_t* gp = G + (size_t)(row0 + ai * HALF + m * 16) * 2048 + col0;
#pragma unroll
                for (int bj = 0; bj < 2; ++bj) { f32x4 a0, a1, b0, b1; unpack8(*(const u32x4*)(gp + bj * HALF), a0, a1); unpack8(*(const u32x4*)(gp + 1024 + bj * HALF), b0, b1);
#pragma unroll
                    for (int i = 0; i < 4; ++i) { acc[ai][bj][m][0][i] *= a0[i] * __builtin_amdgcn_rcpf(fmaxf(b0[i], 1e-30f)); acc[ai][bj][m][1][i] *= a1[i] * __builtin_amdgcn_rcpf(fmaxf(b1[i], 1e-30f)); } } }
    }
    __device__ __forceinline__ void operator()(const f32x4 (&acc)[2][2][4][2], const Unit& u, int wr, int wc, int fr, int fq) const {
        const int row0 = u.pm * BM + wr * 64 + fr, col0 = u.pn * BM + wc * 32 + 8 * fq;
#pragma unroll
        for (int ai = 0; ai < 2; ++ai)
#pragma unroll
            for (int m = 0; m < 4; ++m) { const size_t r = (size_t)(row0 + ai * HALF + m * 16); bf16_t* rowp = O + r * 1024 + col0; const bf16_t* gp = G + r * 2048 + 1024 + col0;
#pragma unroll
                for (int bj = 0; bj < 2; ++bj) { f32x4 g0, g1; unpack8(*(const u32x4*)(gp + bj * HALF), g0, g1);
                    *(u32x4*)(rowp + bj * HALF) = pack8(acc[ai][bj][m][0] * g0, acc[ai][bj][m][1] * g1); } }
    }
};
}
#define LAS __attribute__((address_space(3)))
#define XB_TMO      128
#define XB_XCNT(j)  (256  + 64 * (j))
#define XB_XSUB(j)  (1280 + 64 * (j))
#define XB_XGEN(j)  (2304 + 64 * (j))
#define XB_TOP      3328
#define XB_TOPGEN   3392
#define XCD_BAR_WORDS 3456
#define XB_SPIN_CAP (1u << 18)

__device__ __forceinline__ unsigned xb_ld(unsigned* p)              { return __hip_atomic_load(p, __ATOMIC_RELAXED, __HIP_MEMORY_SCOPE_AGENT); }
__device__ __forceinline__ unsigned xb_add(unsigned* p, unsigned v) { return __hip_atomic_fetch_add(p, v, __ATOMIC_RELAXED, __HIP_MEMORY_SCOPE_AGENT); }
__device__ __forceinline__ unsigned xb_xcc_id() { return (unsigned)__builtin_amdgcn_s_getreg((3 << 11) | 20) & 0xFu; }
#define XB_SPIN(cond, bar) do { unsigned _sp = 0; while (cond) { __builtin_amdgcn_s_sleep(1); \
    if ((++_sp & 255u) == 0u) { if (xb_ld(&(bar)[XB_TMO])) break; if (_sp > XB_SPIN_CAP) { atomicAdd(&(bar)[XB_TMO], 1u); break; } } } } while (0)

struct XcdBarrier {
    unsigned* bar; unsigned x;
    volatile LAS unsigned* st;
};

__device__ __forceinline__ XcdBarrier xcd_barrier_post(unsigned* bar, volatile LAS unsigned* st) {
    XcdBarrier b; b.bar = bar; b.x = xb_xcc_id(); b.st = st;
    if (threadIdx.x == 0) (void)xb_add(&bar[XB_XCNT(b.x)], 1u);
    return b;
}
__device__ __forceinline__ void xcd_barrier_complete(unsigned* bar, unsigned x, unsigned& nloc, unsigned& nx) {
    const unsigned G = gridDim.x * gridDim.y * gridDim.z;
    unsigned sum, cnt, mine, sp = 0u;
    for (;;) {
        sum = 0u; cnt = 0u; mine = 0u;
#pragma unroll
        for (unsigned j = 0; j < 16; ++j) { const unsigned c = xb_ld(&bar[XB_XCNT(j)]); sum += c; cnt += (c > 0u) ? 1u : 0u; mine = (j == x) ? c : mine; }
        if (sum == G) break;
        __builtin_amdgcn_s_sleep(1);
        if ((++sp & 255u) == 0u) { if (xb_ld(&bar[XB_TMO])) break; if (sp > XB_SPIN_CAP) { atomicAdd(&bar[XB_TMO], 1u); break; } }
    }
    nloc = mine > 0u ? mine : 1u; nx = cnt > 0u ? cnt : 1u;
}

__device__ __forceinline__ void xcd_barrier(const XcdBarrier& b) {
    asm volatile("s_waitcnt vmcnt(0)" ::: "memory");
    __syncthreads();
    if (threadIdx.x == 0) {
        unsigned* bar = b.bar;
        __builtin_amdgcn_s_waitcnt(0);
        unsigned nloc = b.st[0], nx = b.st[1];
        if (nloc == 0u) { xcd_barrier_complete(bar, b.x, nloc, nx); b.st[0] = nloc; b.st[1] = nx; }
        const unsigned old = xb_add(&bar[XB_XSUB(b.x)], 1u);
        const unsigned gen = old / nloc;
        if (old + 1u == (gen + 1u) * nloc) {
            __builtin_amdgcn_fence(__ATOMIC_RELEASE, "agent");
            asm volatile("s_waitcnt vmcnt(0)" ::: "memory");
            const unsigned og = xb_add(&bar[XB_TOP], 1u);
            const unsigned tg = og / nx;
            if (og + 1u == (tg + 1u) * nx) xb_add(&bar[XB_TOPGEN], 1u);
            else XB_SPIN(xb_ld(&bar[XB_TOPGEN]) == tg, bar);
            __builtin_amdgcn_fence(__ATOMIC_ACQUIRE, "agent");
            xb_add(&bar[XB_XGEN(b.x)], 1u);
            asm volatile("s_waitcnt vmcnt(0)" ::: "memory");
        } else {
            XB_SPIN(xb_ld(&bar[XB_XGEN(b.x)]) == gen, bar);
            __builtin_amdgcn_fence(__ATOMIC_ACQUIRE, "agent");
            asm volatile("s_waitcnt vmcnt(0)" ::: "memory");
        }
    }
    __syncthreads();
}

#ifndef MK_N_LAUNCHES
#define MK_N_LAUNCHES 1
#endif
constexpr int NWAVES = 8;
constexpr int BATCH = 4, SEQ = 8192, D = 1024, FF = 2816, DA = 512, DC = 512, NH = 8, HD = 64;
constexpr int M = BATCH * SEQ;
constexpr int NGU = 2 * FF;
constexpr int NMIX = 4096;
constexpr float EPS = 1e-6f;
constexpr float LOG2E = 1.4426950408889634f;
constexpr float QSCALE = 0.125f * LOG2E;

constexpr size_t MiB = 1u << 20;
constexpr size_t WS_WGU1 = 2 * MiB;
constexpr size_t WS_WD1 = WS_WGU1 + (size_t)NGU * D * 2;
constexpr size_t WS_WGU2 = WS_WD1 + (size_t)D * FF * 2;
constexpr size_t WS_WD2 = WS_WGU2 + (size_t)NGU * D * 2;
constexpr size_t WS_WMIX = WS_WD2 + (size_t)D * FF * 2;
constexpr size_t WS_WV = WS_WMIX + (size_t)NMIX * D * 2;
constexpr size_t WS_WAO = WS_WV + (size_t)DA * D * 2;
constexpr size_t WS_WCO = WS_WAO + (size_t)D * DA * 2;
constexpr size_t WS_WOUT = WS_WCO + (size_t)D * DC * 2;
constexpr size_t WS_WEND = WS_WOUT + (size_t)D * D * 2;
static_assert(WS_WEND <= 50 * MiB, "weights");
constexpr size_t WS_XN = 50 * MiB;
constexpr size_t WS_F = 114 * MiB;
constexpr size_t WS_H = 178 * MiB;
constexpr size_t WS_BIG = 306 * MiB;
constexpr size_t WS_Q = WS_BIG, WS_K = WS_BIG + 32 * MiB, WS_VT = WS_BIG + 64 * MiB, WS_C = WS_BIG + 96 * MiB, WS_O = WS_BIG + 128 * MiB, WS_CB = WS_BIG + 160 * MiB;
constexpr size_t WS_END = 512 * MiB;
static_assert(WS_BIG + (size_t)M * FF * 2 <= WS_END && WS_CB + 32 * MiB <= WS_END, "d_ws map");

constexpr int RING_BYTES = 131072;
constexpr int LDS_BYTES = 147456;

typedef unsigned short bf16;
typedef unsigned v4u __attribute__((ext_vector_type(4)));
typedef unsigned v2u __attribute__((ext_vector_type(2)));
typedef float f32x4 __attribute__((ext_vector_type(4)));
typedef float f32x2 __attribute__((ext_vector_type(2)));
typedef float f32x16 __attribute__((ext_vector_type(16)));
typedef short bf16x8 __attribute__((ext_vector_type(8)));
typedef short s16x4 __attribute__((ext_vector_type(4)));
typedef __bf16 bf16x2_t __attribute__((ext_vector_type(2)));
#define LDS_WAIT() asm volatile("s_waitcnt lgkmcnt(0)" ::: "memory")
__device__ __forceinline__ unsigned pk2(float lo, float hi) { f32x2 v = {lo, hi}; bf16x2_t b = __builtin_convertvector(v, bf16x2_t); return __builtin_bit_cast(unsigned, b); }
__device__ __forceinline__ float bf_lo(unsigned u) { return __uint_as_float(u << 16); }
__device__ __forceinline__ float bf_hi(unsigned u) { return __uint_as_float(u & 0xffff0000u); }
__device__ __forceinline__ float wave_sum(float v) {
#pragma unroll
    for (int o = 1; o < 64; o <<= 1) v += __shfl_xor(v, o);
    return v;
}

__device__ __forceinline__ void p0_transpose_item(const float* W, int N, int k0, int n0, bf16* dst, int Kd, LAS float* scr, int lane) {
#pragma unroll 8
    for (int i = 0; i < 32; ++i) { const int kk = 2 * i + (lane >> 5); scr[kk * 33 + (lane & 31)] = W[(size_t)(k0 + kk) * N + n0 + (lane & 31)]; }
    LDS_WAIT(); asm volatile("" ::: "memory");
    const int c = lane & 7;
#pragma unroll
    for (int j = 0; j < 4; ++j) { const int n = (lane >> 3) + 8 * j; const LAS float* s = scr + (8 * c) * 33 + n;
        v4u o; o.x = pk2(s[0 * 33], s[1 * 33]); o.y = pk2(s[2 * 33], s[3 * 33]); o.z = pk2(s[4 * 33], s[5 * 33]); o.w = pk2(s[6 * 33], s[7 * 33]);
        *(v4u*)(dst + (size_t)n * Kd + k0 + 8 * c) = o; }
    LDS_WAIT(); asm volatile("" ::: "memory");
}
__device__ __forceinline__ void rms_row_to_bf16(const float* xrow, const float* g, bf16* orow, int lane) {
    const f32x4* xr = (const f32x4*)xrow + lane; const f32x4* gr = (const f32x4*)g + lane;
    f32x4 v[4]; float s = 0.f;
#pragma unroll
    for (int j = 0; j < 4; ++j) { v[j] = xr[64 * j]; s += (v[j].x * v[j].x + v[j].y * v[j].y) + (v[j].z * v[j].z + v[j].w * v[j].w); }
    const float rs = 1.0f / sqrtf(wave_sum(s) * (1.f / D) + EPS);
    v2u* o8 = (v2u*)orow + lane;
#pragma unroll
    for (int j = 0; j < 4; ++j) { const f32x4 gg = gr[64 * j]; v2u o; o.x = pk2(v[j].x * rs * gg.x, v[j].y * rs * gg.y); o.y = pk2(v[j].z * rs * gg.z, v[j].w * rs * gg.w); o8[64 * j] = o; }
}
struct WPtrs { const float *g1, *u1, *d1, *g2, *u2, *d2, *win, *wao, *wco, *wout; };
__device__ __forceinline__ void p0_prologue(LAS unsigned char* lds, const WPtrs& P, unsigned char* ws, const float* x, const float* gpre, int G, int bid, int wave, int lane) {
    LAS float* scr = (LAS float*)(lds + wave * 16384);
    const int gw = bid * NWAVES + wave, NGW = G * NWAVES;
    constexpr int I_GU = (D / 64) * (FF / 32), I_DN = (FF / 64) * (D / 32), I_IN = (D / 64) * (4608 / 32), I_AO = (DA / 64) * (D / 32), I_WO = (D / 64) * (D / 32);
    constexpr int NITEMS = 4 * I_GU + 2 * I_DN + I_IN + 2 * I_AO + I_WO;
    bf16* XN = (bf16*)(ws + WS_XN);
    for (int m = gw; m < M; m += NGW) rms_row_to_bf16(x + (size_t)m * D, gpre, XN + (size_t)m * D, lane);
    for (int it = gw; it < NITEMS; it += NGW) {
        int r = it;
        if (r < 4 * I_GU) {
            const int which = r / I_GU; r -= which * I_GU; const int nblk = FF / 32, kb = r / nblk, nb = r % nblk, n0 = 32 * nb;
            const float* W = which == 0 ? P.g1 : which == 1 ? P.u1 : which == 2 ? P.g2 : P.u2;
            bf16* WT = (bf16*)(ws + (which < 2 ? WS_WGU1 : WS_WGU2));
            const int drow = 256 * (n0 >> 7) + 128 * (which & 1) + (n0 & 127);
            p0_transpose_item(W, FF, 64 * kb, n0, WT + (size_t)drow * D, D, scr, lane); continue; }
        r -= 4 * I_GU;
        if (r < 2 * I_DN) {
            const int which = r / I_DN; r -= which * I_DN; const int nblk = D / 32, kb = r / nblk, nb = r % nblk, n0 = 32 * nb;
            p0_transpose_item(which == 0 ? P.d1 : P.d2, D, 64 * kb, n0, (bf16*)(ws + (which == 0 ? WS_WD1 : WS_WD2)) + (size_t)n0 * FF, FF, scr, lane); continue; }
        r -= 2 * I_DN;
        if (r < I_IN) {
            const int nblk = 4608 / 32, kb = r / nblk, nb = r % nblk, n0 = 32 * nb;
            bf16* dst;
            if (n0 < 1024) dst = (bf16*)(ws + WS_WMIX) + (size_t)n0 * D;
            else if (n0 < 1536) dst = (bf16*)(ws + WS_WV) + (size_t)(n0 - 1024) * D;
            else if (n0 < 2048) { const int c = n0 - 1536; dst = (bf16*)(ws + WS_WMIX) + (size_t)(1024 + 256 * (c >> 7) + (c & 127)) * D; }
            else if (n0 < 2560) { const int c = n0 - 2048; dst = (bf16*)(ws + WS_WMIX) + (size_t)(1024 + 256 * (c >> 7) + 128 + (c & 127)) * D; }
            else dst = (bf16*)(ws + WS_WMIX) + (size_t)(2048 + (n0 - 2560)) * D;
            p0_transpose_item(P.win, 4608, 64 * kb, n0, dst, D, scr, lane); continue; }
        r -= I_IN;
        if (r < 2 * I_AO) {
            const int which = r / I_AO; r -= which * I_AO; const int nblk = D / 32, kb = r / nblk, nb = r % nblk, n0 = 32 * nb;
            p0_transpose_item(which == 0 ? P.wao : P.wco, D, 64 * kb, n0, (bf16*)(ws + WS_WAO) + (size_t)n0 * D + which * DA, D, scr, lane); continue; }
        r -= 2 * I_AO;
        { const int nblk = D / 32, kb = r / nblk, nb = r % nblk, n0 = 32 * nb;
          p0_transpose_item(P.wout, D, 64 * kb, n0, (bf16*)(ws + WS_WOUT) + (size_t)n0 * D, D, scr, lane); }
    }
}

template <bool BASE_BF16, bool OUT_BF16>
__device__ __forceinline__ void row_pass(const void* base, const bf16* f, const float* gpost, float scale, void* hout, const float* gnext, bf16* xn, int G, int bid, int wave, int lane) {
    const int gw = bid * NWAVES + wave, NGW = G * NWAVES;
    const f32x4* gp = (const f32x4*)gpost + lane; const f32x4* gn = (const f32x4*)gnext + lane;
    for (int m0 = gw; m0 < M; m0 += 2 * NGW) {
        f32x4 fv[2][4], bv[2][4]; float s[2];
#pragma unroll
        for (int q = 0; q < 2; ++q) { const int m = m0 + q * NGW; if (m < M) {
            const v2u* fr = (const v2u*)(f + (size_t)m * D) + lane;
#pragma unroll
            for (int j = 0; j < 4; ++j) { const v2u w = fr[64 * j]; fv[q][j] = (f32x4){bf_lo(w.x), bf_hi(w.x), bf_lo(w.y), bf_hi(w.y)}; }
            if (BASE_BF16) { const v2u* br = (const v2u*)((const bf16*)base + (size_t)m * D) + lane;
#pragma unroll
                for (int j = 0; j < 4; ++j) { const v2u w = br[64 * j]; bv[q][j] = (f32x4){bf_lo(w.x), bf_hi(w.x), bf_lo(w.y), bf_hi(w.y)}; } }
            else { const f32x4* br = (const f32x4*)((const float*)base + (size_t)m * D) + lane;
#pragma unroll
                for (int j = 0; j < 4; ++j) bv[q][j] = br[64 * j]; } } }
#pragma unroll
        for (int q = 0; q < 2; ++q) { s[q] = 0.f;
#pragma unroll
            for (int j = 0; j < 4; ++j) s[q] += (fv[q][j].x * fv[q][j].x + fv[q][j].y * fv[q][j].y) + (fv[q][j].z * fv[q][j].z + fv[q][j].w * fv[q][j].w); }
#pragma unroll
        for (int o = 1; o < 64; o <<= 1) { s[0] += __shfl_xor(s[0], o); s[1] += __shfl_xor(s[1], o); }
        float s2[2];
#pragma unroll
        for (int q = 0; q < 2; ++q) { const int m = m0 + q * NGW; const float rs = scale / sqrtf(s[q] * (1.f / D) + EPS); s2[q] = 0.f;
#pragma unroll
            for (int j = 0; j < 4; ++j) { const f32x4 gg = gp[64 * j]; bv[q][j] = bv[q][j] + fv[q][j] * rs * gg; }
            if (m < M) {
                if (OUT_BF16) { v2u* ho = (v2u*)((bf16*)hout + (size_t)m * D) + lane;
#pragma unroll
                    for (int j = 0; j < 4; ++j) { v2u o; o.x = pk2(bv[q][j].x, bv[q][j].y); o.y = pk2(bv[q][j].z, bv[q][j].w); ho[64 * j] = o;
                        bv[q][j] = (f32x4){bf_lo(o.x), bf_hi(o.x), bf_lo(o.y), bf_hi(o.y)}; } }
                else { f32x4* ho = (f32x4*)((float*)hout + (size_t)m * D) + lane;
#pragma unroll
                    for (int j = 0; j < 4; ++j) ho[64 * j] = bv[q][j]; } }
#pragma unroll
            for (int j = 0; j < 4; ++j) s2[q] += (bv[q][j].x * bv[q][j].x + bv[q][j].y * bv[q][j].y) + (bv[q][j].z * bv[q][j].z + bv[q][j].w * bv[q][j].w); }
        if (gnext) {
#pragma unroll
            for (int o = 1; o < 64; o <<= 1) { s2[0] += __shfl_xor(s2[0], o); s2[1] += __shfl_xor(s2[1], o); }
#pragma unroll
            for (int q = 0; q < 2; ++q) { const int m = m0 + q * NGW; if (m < M) { const float rs2 = 1.0f / sqrtf(s2[q] * (1.f / D) + EPS);
                v2u* o8 = (v2u*)(xn + (size_t)m * D) + lane;
#pragma unroll
                for (int j = 0; j < 4; ++j) { const f32x4 gg = gn[64 * j]; v2u o; o.x = pk2(bv[q][j].x * rs2 * gg.x, bv[q][j].y * rs2 * gg.y); o.y = pk2(bv[q][j].z * rs2 * gg.z, bv[q][j].w * rs2 * gg.w); o8[64 * j] = o; } } }
        }
    }
}

__device__ __forceinline__ int crow(int r, int hi) { return (r & 3) + 8 * (r >> 2) + 4 * hi; }
#define MFMA32(a, b, c) __builtin_amdgcn_mfma_f32_32x32x16_bf16((a), (b), (c), 0, 0, 0)
__device__ __forceinline__ void attn_phase(LAS unsigned char* lds, const bf16* Q, const bf16* Kb, const bf16* Vt, bf16* O, const float* rel_table, int G, int bid) {
    const int tid = threadIdx.x, lane = tid & 63, r = lane & 31, hi = lane >> 5; const int w = __builtin_amdgcn_readfirstlane(tid >> 6);
    constexpr int PITCH = 144, TILE = 64 * PITCH;
    LAS unsigned char* Ks = lds; LAS unsigned char* Vs = lds + 2 * TILE; LAS float* tbl = (LAS float*)(lds + 4 * TILE);
    const int srow = tid >> 3, sc = tid & 7, soff = srow * PITCH + sc * 16;
    for (int u = bid; u < BATCH * NH * 32; u += G) {
        const int cg4 = u & 31, h = (u >> 5) & 7, b = u >> 8;
        const int c0 = cg4 * 4, c = c0 + (w >> 1);
        const int kt_first = c0 - 8 > 0 ? c0 - 8 : 0, kt_last = c0 + 3;
        const size_t tokb = (size_t)b * SEQ;
        if (tid < 257) tbl[tid] = (rel_table[h * 257 + tid] - rel_table[h * 257 + 256]) * LOG2E;
        const int qpos = c * 64 + 32 * (w & 1) + r;
        bf16x8 qf[4];
        { const bf16* qp = Q + (tokb + qpos) * DA + h * HD + 8 * hi;
#pragma unroll
          for (int d0 = 0; d0 < 4; ++d0) qf[d0] = *(const bf16x8*)(qp + 16 * d0); }
        f32x16 o0, o1;
#pragma unroll
        for (int i = 0; i < 16; ++i) { o0[i] = 0.f; o1[i] = 0.f; }
        float mrow = 0.f, lsum = 0.f; f32x16 negm;
#pragma unroll
        for (int i = 0; i < 16; ++i) negm[i] = 0.f;
        const bf16* kg = Kb + (tokb + srow) * DA + h * HD + sc * 8;
        const bf16* vg = Vt + (size_t)(h * HD + srow) * M + tokb + sc * 8;
        v4u kregA = *(const v4u*)(kg + (size_t)kt_first * 64 * DA), vregA = *(const v4u*)(vg + kt_first * 64);
        v4u kregB = *(const v4u*)(kg + (size_t)(kt_first + 1) * 64 * DA), vregB = *(const v4u*)(vg + (kt_first + 1) * 64);
        *(LAS v4u*)(Ks + soff) = kregA; *(LAS v4u*)(Vs + soff) = vregA;
        __syncthreads();
        int cur = 0;
        for (int kt2 = kt_first; kt2 <= kt_last; kt2 += 2) {
#pragma unroll
          for (int hf = 0; hf < 2; ++hf) {
            const int kt = kt2 + hf;
            if (kt + 2 <= kt_last) {
                if (hf == 0) { kregA = *(const v4u*)(kg + (size_t)(kt + 2) * 64 * DA); vregA = *(const v4u*)(vg + (kt + 2) * 64); }
                else { kregB = *(const v4u*)(kg + (size_t)(kt + 2) * 64 * DA); vregB = *(const v4u*)(vg + (kt + 2) * 64); } }
            if (kt >= c - 8 && kt <= c) {
                const LAS unsigned char* kb = Ks + cur * TILE + r * PITCH + hi * 16;
                const bool nearT = kt >= c - 2;
                const bool first = kt == (c - 8 > 0 ? c - 8 : 0);
                f32x16 p0, p1;
                bf16x8 kf[8];
#pragma unroll
                for (int d0 = 0; d0 < 4; ++d0) { kf[2 * d0] = *(const LAS bf16x8*)(kb + d0 * 32); kf[2 * d0 + 1] = *(const LAS bf16x8*)(kb + 32 * PITCH + d0 * 32); }
                __builtin_amdgcn_sched_barrier(0);
#pragma unroll
                for (int d0 = 0; d0 < 4; ++d0) {
                    if (d0 == 0) { p0 = MFMA32(kf[0], qf[0], negm); p1 = MFMA32(kf[1], qf[0], negm); }
                    else { p0 = MFMA32(kf[2 * d0], qf[d0], p0); p1 = MFMA32(kf[2 * d0 + 1], qf[d0], p1); } }
                if (nearT) {
                    const int dbase = qpos - kt * 64 - 4 * hi;
#pragma unroll
                    for (int i = 0; i < 16; ++i) { int d_ = dbase - ((i & 3) + 8 * (i >> 2));
                        int i0 = d_ < -128 ? -128 : (d_ > 128 ? 128 : d_); int d1 = d_ - 32; int i1 = d1 < -128 ? -128 : (d1 > 128 ? 128 : d1);
                        p0[i] += tbl[i0 + 128]; p1[i] += tbl[i1 + 128]; }
                }
                float mx = fmaxf(fmaxf(p0[0], p0[1]), p1[0]);
#pragma unroll
                for (int i = 2; i < 16; i += 2) mx = fmaxf(fmaxf(mx, p0[i]), p0[i + 1]);
#pragma unroll
                for (int i = 1; i < 15; i += 2) mx = fmaxf(fmaxf(mx, p1[i]), p1[i + 1]);
                mx = fmaxf(mx, p1[15]);
                mx = fmaxf(mx, __shfl_xor(mx, 32));
                if (first || __any(mx > 8.0f)) {
                    const float delta = first ? mx : fmaxf(mx, 0.f);
#pragma unroll
                    for (int i = 0; i < 16; ++i) { p0[i] -= delta; p1[i] -= delta; }
                    mrow += delta;
#pragma unroll
                    for (int i = 0; i < 16; ++i) negm[i] = -mrow;
                    if (!first) { const float fsc = __builtin_amdgcn_exp2f(-delta); lsum *= fsc;
#pragma unroll
                        for (int i = 0; i < 16; ++i) { o0[i] *= fsc; o1[i] *= fsc; } }
                }
                float ps = 0.f;
#pragma unroll
                for (int i = 0; i < 16; ++i) { p0[i] = __builtin_amdgcn_exp2f(p0[i]); p1[i] = __builtin_amdgcn_exp2f(p1[i]); ps += p0[i] + p1[i]; }
                lsum += ps;
                bf16x8 pf[4];
                { v4u t;
                  t.x = pk2(p0[0], p0[1]); t.y = pk2(p0[2], p0[3]); t.z = pk2(p0[4], p0[5]); t.w = pk2(p0[6], p0[7]); pf[0] = __builtin_bit_cast(bf16x8, t);
                  t.x = pk2(p0[8], p0[9]); t.y = pk2(p0[10], p0[11]); t.z = pk2(p0[12], p0[13]); t.w = pk2(p0[14], p0[15]); pf[1] = __builtin_bit_cast(bf16x8, t);
                  t.x = pk2(p1[0], p1[1]); t.y = pk2(p1[2], p1[3]); t.z = pk2(p1[4], p1[5]); t.w = pk2(p1[6], p1[7]); pf[2] = __builtin_bit_cast(bf16x8, t);
                  t.x = pk2(p1[8], p1[9]); t.y = pk2(p1[10], p1[11]); t.z = pk2(p1[12], p1[13]); t.w = pk2(p1[14], p1[15]); pf[3] = __builtin_bit_cast(bf16x8, t); }
                const LAS unsigned char* vb = Vs + cur * TILE + r * PITCH + hi * 8;
                bf16x8 vfa[4], vfb[4];
#pragma unroll
                for (int s = 0; s < 4; ++s) {
                    const int kvb = ((s >> 1) * 32 + (s & 1) * 16) * 2;
                    const s16x4 a0 = *(const LAS s16x4*)(vb + kvb), a1 = *(const LAS s16x4*)(vb + kvb + 16);
                    const s16x4 b0 = *(const LAS s16x4*)(vb + 32 * PITCH + kvb), b1 = *(const LAS s16x4*)(vb + 32 * PITCH + kvb + 16);
                    vfa[s] = __builtin_shufflevector(a0, a1, 0, 1, 2, 3, 4, 5, 6, 7); vfb[s] = __builtin_shufflevector(b0, b1, 0, 1, 2, 3, 4, 5, 6, 7); }
                __builtin_amdgcn_sched_barrier(0);
#pragma unroll
                for (int s = 0; s < 4; ++s) { o0 = MFMA32(vfa[s], pf[s], o0); o1 = MFMA32(vfb[s], pf[s], o1); }
            }
            if (kt + 1 <= kt_last) {
                if (hf == 0) { *(LAS v4u*)(Ks + (cur ^ 1) * TILE + soff) = kregB; *(LAS v4u*)(Vs + (cur ^ 1) * TILE + soff) = vregB; }
                else { *(LAS v4u*)(Ks + (cur ^ 1) * TILE + soff) = kregA; *(LAS v4u*)(Vs + (cur ^ 1) * TILE + soff) = vregA; } }
            __syncthreads();
            cur ^= 1;
          }
        }
        lsum += __shfl_xor(lsum, 32);
        const float inv = 1.0f / lsum;
        bf16* op = O + (tokb + qpos) * D + h * HD + 4 * hi;
#pragma unroll
        for (int g = 0; g < 4; ++g) {
            v2u a; a.x = pk2(o0[4 * g] * inv, o0[4 * g + 1] * inv); a.y = pk2(o0[4 * g + 2] * inv, o0[4 * g + 3] * inv); *(v2u*)(op + 8 * g) = a;
            v2u bb; bb.x = pk2(o1[4 * g] * inv, o1[4 * g + 1] * inv); bb.y = pk2(o1[4 * g + 2] * inv, o1[4 * g + 3] * inv); *(v2u*)(op + 32 + 8 * g) = bb; }
    }
}

__device__ __forceinline__ void conv_phase(LAS unsigned char* lds, const bf16* Cin, const float* dw_w, const float* dw_b, const float* ln_g, const float* ln_b, bf16* CB, int G, int bid) {
    const int tid = threadIdx.x, lane = tid & 63; const int w = __builtin_amdgcn_readfirstlane(tid >> 6);
    LAS unsigned char* tin = lds; LAS float* tout = (LAS float*)(lds + 62 * 1024);
    const int cp = tid & 255, rh = tid >> 8;
    for (int u = bid; u < M / 32; u += G) {
        const int t0 = u * 32, s0 = t0 & (SEQ - 1);
        { v4u tv[8];
#pragma unroll
          for (int i = 0; i < 8; ++i) { const int p = tid + 512 * i, row = p >> 6, c16 = p & 63; tv[i] = (v4u){0u, 0u, 0u, 0u};
              if (p < 62 * 64 && s0 - 30 + row >= 0) tv[i] = *(const v4u*)(Cin + (size_t)(t0 - 30 + row) * DC + c16 * 8); }
#pragma unroll
          for (int i = 0; i < 8; ++i) { const int p = tid + 512 * i, row = p >> 6, c16 = p & 63;
              if (p < 62 * 64) *(LAS v4u*)(tin + row * 1024 + c16 * 16) = tv[i]; } }
        __syncthreads();
        { f32x2 in[46];
#pragma unroll
          for (int i = 0; i < 46; ++i) { const unsigned v = *(const LAS unsigned*)(tin + (16 * rh + i) * 1024 + cp * 4); in[i] = (f32x2){bf_lo(v), bf_hi(v)}; }
          f32x2 acc[16];
          { const f32x2 bb = *(const f32x2*)(dw_b + 2 * cp);
#pragma unroll
            for (int t = 0; t < 16; ++t) acc[t] = bb; }
#pragma unroll
          for (int j = 0; j < 31; ++j) { const f32x2 ww = *(const f32x2*)(dw_w + j * DC + 2 * cp);
#pragma unroll
              for (int t = 0; t < 16; ++t) acc[t] += ww * in[t + j]; }
#pragma unroll
          for (int t = 0; t < 16; ++t) *(LAS f32x2*)(tout + (16 * rh + t) * DC + 2 * cp) = acc[t]; }
        __syncthreads();
        const f32x4 g0 = *(const f32x4*)(ln_g + lane * 8), g1 = *(const f32x4*)(ln_g + lane * 8 + 4), b0 = *(const f32x4*)(ln_b + lane * 8), b1 = *(const f32x4*)(ln_b + lane * 8 + 4);
#pragma unroll
        for (int rr = 0; rr < 4; ++rr) { const int row = 4 * w + rr;
            f32x4 v0 = *(const LAS f32x4*)(tout + row * DC + lane * 8), v1 = *(const LAS f32x4*)(tout + row * DC + lane * 8 + 4);
            const float mean = wave_sum((v0.x + v0.y) + (v0.z + v0.w) + (v1.x + v1.y) + (v1.z + v1.w)) * (1.f / DC);
            v0 = v0 - mean; v1 = v1 - mean;
            const float var = wave_sum((v0.x * v0.x + v0.y * v0.y) + (v0.z * v0.z + v0.w * v0.w) + (v1.x * v1.x + v1.y * v1.y) + (v1.z * v1.z + v1.w * v1.w)) * (1.f / DC);
            const float rstd = 1.0f / sqrtf(var + EPS);
            v0 = v0 * rstd * g0 + b0; v1 = v1 * rstd * g1 + b1;
            v0 = v0 * pg8::sigm4(v0); v1 = v1 * pg8::sigm4(v1);
            v4u o; o.x = pk2(v0.x, v0.y); o.y = pk2(v0.z, v0.w); o.z = pk2(v1.x, v1.y); o.w = pk2(v1.z, v1.w);
            *(v4u*)(CB + (size_t)(t0 + row) * D + DC + lane * 8) = o; }
        __syncthreads();
    }
}

struct Args { const float* in[24]; float* out; unsigned char* ws; int ph_lo, ph_hi; };
__global__ void __launch_bounds__(NWAVES * 64, 2) mega_fwd(Args a) {
    extern __shared__ __attribute__((aligned(16))) unsigned char lds_raw[];
    cg::grid_group grid = cg::this_grid();
    LAS unsigned char* lds = (LAS unsigned char*)lds_raw;
    const int tid = threadIdx.x, lane = tid & 63, wave = __builtin_amdgcn_readfirstlane(tid >> 6);
    const int G = gridDim.x, bid = blockIdx.x;
    unsigned char* ws = a.ws;
    bf16* XN = (bf16*)(ws + WS_XN); bf16* F = (bf16*)(ws + WS_F); bf16* H = (bf16*)(ws + WS_H); bf16* HB = (bf16*)(ws + WS_BIG);
    bf16* Qb = (bf16*)(ws + WS_Q); bf16* Kb = (bf16*)(ws + WS_K); bf16* Vt = (bf16*)(ws + WS_VT); bf16* Cb = (bf16*)(ws + WS_C); bf16* Ob = (bf16*)(ws + WS_O); bf16* CBb = Ob;
    bf16* MERGED = XN;
    bf16* GT = (bf16*)a.out;
    const float* x = a.in[0];
    volatile LAS unsigned* MISC = (volatile LAS unsigned*)(lds + RING_BYTES);
    if (tid < 16) MISC[tid] = 0u;
    if (bid == 0) {
        for (int i = tid; i < 4096; i += NWAVES * 64) ((unsigned*)ws)[i] = 0u;
        asm volatile("s_waitcnt vmcnt(0)" ::: "memory"); __builtin_amdgcn_fence(__ATOMIC_RELEASE, "agent"); asm volatile("s_waitcnt vmcnt(0)" ::: "memory");
    }
    __syncthreads();
    grid.sync();
    XcdBarrier bar = xcd_barrier_post((unsigned*)ws, MISC + 8);
#define GRID_SYNC() xcd_barrier(bar)

    if (a.ph_lo <= 0 && 0 < a.ph_hi) {
    { WPtrs P{a.in[2], a.in[3], a.in[4], a.in[20], a.in[21], a.in[22], a.in[7], a.in[10], a.in[16], a.in[17]};
      p0_prologue(lds, P, ws, x, a.in[1], G, bid, wave, lane); }
    if (a.ph_lo <= 0 && 1 < a.ph_hi) GRID_SYNC();
    }
    if (a.ph_lo <= 1 && 1 < a.ph_hi) {
    { pg8::Gemm g{XN, (const bf16*)(ws + WS_WGU1), M, NGU, D, D}; pg8::StaticOrder S; S.init(M, NGU, G, bid);
      pg8::EpiSwiGLU E{HB, FF}; pg8::gemm_phase<pg8::EpiSwiGLU, pg8::StaticOrder, true, true>(lds, g, S, E); }
    if (a.ph_lo <= 1 && 2 < a.ph_hi) GRID_SYNC();
    }
    if (a.ph_lo <= 2 && 2 < a.ph_hi) {
    { pg8::Gemm g{HB, (const bf16*)(ws + WS_WD1), M, D, FF, FF}; pg8::StaticOrder S; S.init(M, D, G, bid);
      pg8::EpiStore E{F, D}; pg8::gemm_phase<pg8::EpiStore, pg8::StaticOrder, true, true>(lds, g, S, E); }
    if (a.ph_lo <= 2 && 3 < a.ph_hi) GRID_SYNC();
    }
    if (a.ph_lo <= 3 && 3 < a.ph_hi) {
    row_pass<false, true>(x, F, a.in[5], 0.5f, H, a.in[6], XN, G, bid, wave, lane);
    if (a.ph_lo <= 3 && 4 < a.ph_hi) GRID_SYNC();
    }
    if (a.ph_lo <= 4 && 4 < a.ph_hi) {
    { pg8::Gemm g{XN, (const bf16*)(ws + WS_WMIX), M, NMIX, D, D}; pg8::StaticOrder S; S.init(M, NMIX, G, bid);
      pg8::EpiMix E{Qb, Kb, Cb, GT, a.in[11], a.in[8], QSCALE}; pg8::gemm_phase<pg8::EpiMix, pg8::StaticOrder, true, true>(lds, g, S, E); }
    { pg8::Gemm g{(const bf16*)(ws + WS_WV), XN, DA, M, D, D}; pg8::StaticOrder S; S.init(DA, M, G, bid);
      pg8::EpiStore E{Vt, M}; pg8::gemm_phase<pg8::EpiStore, pg8::StaticOrder, true, true>(lds, g, S, E); }
    if (a.ph_lo <= 4 && 5 < a.ph_hi) GRID_SYNC();
    }
    if (a.ph_lo <= 5 && 5 < a.ph_hi) {
    attn_phase(lds, Qb, Kb, Vt, Ob, a.in[9], G, bid);
    conv_phase(lds, Cb, a.in[12], a.in[13], a.in[14], a.in[15], CBb, G, bid);
    if (a.ph_lo <= 5 && 6 < a.ph_hi) GRID_SYNC();
    }
    if (a.ph_lo <= 6 && 6 < a.ph_hi) {
    { pg8::Gemm g{Ob, (const bf16*)(ws + WS_WAO), M, D, DA, D}; pg8::HalfOrder S; S.init(M, D, G, bid);
      pg8::EpiGateMid E{MERGED, GT}; pg8::gemm_phase<pg8::EpiGateMid, pg8::HalfOrder, true, true>(lds, g, S, E); }
    if (a.ph_lo <= 6 && 7 < a.ph_hi) GRID_SYNC();
    }
    if (a.ph_lo <= 7 && 7 < a.ph_hi) {
    { pg8::Gemm g{MERGED, (const bf16*)(ws + WS_WOUT), M, D, D, D}; pg8::StaticOrder S; S.init(M, D, G, bid);
      pg8::EpiStore E{F, D}; pg8::gemm_phase<pg8::EpiStore, pg8::StaticOrder, true, true>(lds, g, S, E); }
    if (a.ph_lo <= 7 && 8 < a.ph_hi) GRID_SYNC();
    }
    if (a.ph_lo <= 8 && 8 < a.ph_hi) {
    row_pass<true, true>(H, F, a.in[18], 1.0f, H, a.in[19], XN, G, bid, wave, lane);
    if (a.ph_lo <= 8 && 9 < a.ph_hi) GRID_SYNC();
    }
    if (a.ph_lo <= 9 && 9 < a.ph_hi) {
    { pg8::Gemm g{XN, (const bf16*)(ws + WS_WGU2), M, NGU, D, D}; pg8::StaticOrder S; S.init(M, NGU, G, bid);
      pg8::EpiSwiGLU E{HB, FF}; pg8::gemm_phase<pg8::EpiSwiGLU, pg8::StaticOrder, true, true>(lds, g, S, E); }
    if (a.ph_lo <= 9 && 10 < a.ph_hi) GRID_SYNC();
    }
    if (a.ph_lo <= 10 && 10 < a.ph_hi) {
    { pg8::Gemm g{HB, (const bf16*)(ws + WS_WD2), M, D, FF, FF}; pg8::StaticOrder S; S.init(M, D, G, bid);
      pg8::EpiStore E{F, D}; pg8::gemm_phase<pg8::EpiStore, pg8::StaticOrder, true, true>(lds, g, S, E); }
    if (a.ph_lo <= 10 && 11 < a.ph_hi) GRID_SYNC();
    }
    if (a.ph_lo <= 11 && 11 < a.ph_hi) {
    row_pass<true, false>(H, F, a.in[23], 0.5f, a.out, nullptr, nullptr, G, bid, wave, lane);
    }
#ifdef DBG_END
    if (a.ph_lo == 99) {
        const int gw = bid * NWAVES + wave, NGW = G * NWAVES;
        if (DBG_END == 55) { for (int m = gw; m < M; m += NGW) { float* o = a.out + (size_t)m * D; float v[16];
#pragma unroll
            for (int j = 0; j < 16; ++j) v[j] = bf_lo(GT[(size_t)m * 2048 + lane + 64 * j]) + bf_lo(GT[(size_t)m * 2048 + 1024 + lane + 64 * j]);
            asm volatile("s_waitcnt vmcnt(0)" ::: "memory");
#pragma unroll
            for (int j = 0; j < 16; ++j) o[lane + 64 * j] = v[j]; } }
        else for (int m = gw; m < M; m += NGW) { float* o = a.out + (size_t)m * D;
            for (int j = lane; j < D; j += 64) {
                float v;
                if (DBG_END <= 4) v = bf_lo(H[(size_t)m * D + j]);
                else if (DBG_END == 5) v = j < 512 ? bf_lo(Qb[(size_t)m * 512 + j]) + bf_lo(Kb[(size_t)m * 512 + j]) : bf_lo(Cb[(size_t)m * 512 + j - 512]) + bf_lo(Vt[(size_t)(j - 512) * M + m]);
                else if (DBG_END == 6) v = bf_lo(Ob[(size_t)m * D + j]);
                else if (DBG_END == 7) v = bf_lo(MERGED[(size_t)m * D + j]);
                else v = bf_lo(F[(size_t)m * D + j]);
                o[j] = v; } }
    }
#endif
}

extern "C" void kernel_launch(void* const* d_in, const int* in_sizes, int n_in, void* d_out, int out_size, void* d_ws, size_t ws_size, hipStream_t stream) {
    static int grid = 0;
    if (grid == 0) {
        if (n_in != 24 || in_sizes[0] != M * D || out_size != M * D || ws_size < WS_END) { fprintf(stderr, "kernel_launch: unexpected shapes (n_in %d, in0 %d, out %d, ws %zu); nothing launched\n", n_in, n_in > 0 ? in_sizes[0] : -1, out_size, ws_size); grid = -1; return; }
        int dev = 0, cus = 0, per_cu = 0;
        if (hipGetDevice(&dev) != hipSuccess || hipDeviceGetAttribute(&cus, hipDeviceAttributeMultiprocessorCount, dev) != hipSuccess) { grid = -1; return; }
        if (hipFuncSetAttribute((const void*)mega_fwd, hipFuncAttributeMaxDynamicSharedMemorySize, LDS_BYTES) != hipSuccess) { fprintf(stderr, "kernel_launch: hipFuncSetAttribute failed\n"); grid = -1; return; }
        if (hipOccupancyMaxActiveBlocksPerMultiprocessor(&per_cu, (const void*)mega_fwd, NWAVES * 64, LDS_BYTES) != hipSuccess || per_cu < 1) { fprintf(stderr, "kernel_launch: occupancy query reports %d blocks per CU\n", per_cu); (void)hipGetLastError(); grid = -1; return; }
        grid = cus;
    }
    if (grid < 0) return;
    Args a{};
    for (int i = 0; i < 24; ++i) a.in[i] = (const float*)d_in[i];
    a.out = (float*)d_out; a.ws = (unsigned char*)d_ws;
    void* args[] = {&a};
#if MK_N_LAUNCHES == 1
    a.ph_lo = 0; a.ph_hi = 12;
    hipError_t e = hipLaunchCooperativeKernel((const void*)mega_fwd, dim3(grid), dim3(NWAVES * 64), args, LDS_BYTES, stream);
    if (e != hipSuccess) fprintf(stderr, "kernel_launch: cooperative launch failed: %s (grid %d)\n", hipGetErrorString(e), grid);
#else
#ifdef DBG_END
    for (int p = 0; p < (DBG_END == 55 ? 5 : DBG_END); ++p) { a.ph_lo = p; a.ph_hi = p + 1; hipLaunchKernelGGL(mega_fwd, dim3(grid), dim3(NWAVES * 64), LDS_BYTES, stream, a); }
    a.ph_lo = 99; a.ph_hi = 100; hipLaunchKernelGGL(mega_fwd, dim3(grid), dim3(NWAVES * 64), LDS_BYTES, stream, a);
#else
    for (int p = 0; p < 12; ++p) { a.ph_lo = p; a.ph_hi = p + 1; hipLaunchKernelGGL(mega_fwd, dim3(grid), dim3(NWAVES * 64), LDS_BYTES, stream, a); }
#endif
#endif
}
```
